# Optimizing an MI355X kernel written in HIP

```python
import math
import jax, jax.numpy as jnp
from jax import lax
import numpy as np


D_MODEL = 1024
BATCH = 32
SEQ = 2048
DEPTH = 2

CHUNK = 64
QBLOCK = 128
N_HEADS = 8
D_QLAT = 256
D_LAT = 128
D_VHEAD = 64
IDX_HEADS = 8
IDX_DIM = 32
DSA_TOPK_MAX = 256
SSM_GROUPS = 16
SSM_GROUP_DIM = 16
SSM_STATE = 64
W_SSM = SSM_GROUPS * SSM_GROUP_DIM
POOL_WINDOWS = (2, 4, 8, 16)
POOL_GROUPS = 4
POOL_GROUP_DIM = 64
W_POOL = POOL_GROUPS * POOL_GROUP_DIM
W_ATTN = N_HEADS * D_VHEAD
N_BRANCH = 3
D_FF = 2048
CONV_WIDTH = 3
RMS_EPS = 1e-6
NEG_INF = -1e30
ATTN_SCALE = D_LAT ** -0.5
IDX_SCALE = IDX_DIM ** -0.5
IDX_HEAD_SCALE = IDX_HEADS ** -0.5
IN_SPLITS = (D_QLAT, D_LAT, IDX_DIM, IDX_HEADS, W_SSM, W_POOL, N_BRANCH * D_MODEL)
N_IN = 4008

kernel_name = 'chunk_causal_hybrid_dsa_s5_pool_block'


def _rmsnorm(x, g):
    xf = x.astype(jnp.float32)
    y = xf * lax.rsqrt(jnp.mean(xf * xf, axis=-1, keepdims=True) + RMS_EPS)
    return (y * g.astype(jnp.float32)).astype(x.dtype)


def _alibi_slopes(n):
    return jnp.exp2(-8.0 * jnp.arange(1, n + 1, dtype=jnp.float32) / n)


def _dsa_branch(cq, ckv, kidx, widx, g_cq, w_uq, w_qi, g_ckv, w_uv):
    Bsz, S, _ = cq.shape
    cq = _rmsnorm(cq, g_cq)
    ckv = _rmsnorm(ckv, g_ckv)
    q = jnp.einsum('bsr,rhd->bshd', cq, w_uq)
    qi = jnp.einsum('bsr,rhd->bshd', cq, w_qi)
    top_k = min(DSA_TOPK_MAX, S // 4)
    slopes = _alibi_slopes(N_HEADS)
    nb = S // QBLOCK
    key_pos = jnp.arange(S, dtype=jnp.int32)

    def to_blocks(a):
        return jnp.moveaxis(a.reshape((Bsz, nb, QBLOCK) + a.shape[2:]), 1, 0)

    def attend(blk):
        q_b, qi_b, w_b, t_b = blk
        limit = (t_b // CHUNK + 1) * CHUNK
        admissible = key_pos[None, :] < limit[:, None]
        idx_logits = jnp.einsum('bqhd,bsd->bqhs', qi_b, kidx).astype(jnp.float32) * IDX_SCALE
        score = jnp.einsum('bqhs,bqh->bqs', jax.nn.relu(idx_logits), w_b.astype(jnp.float32)) * IDX_HEAD_SCALE
        score = jnp.where(admissible[None], score, NEG_INF)
        _, sel = lax.top_k(score, top_k)
        kv_sel = jax.vmap(lambda kv, i: kv[i])(ckv, sel)
        logits = jnp.einsum('bqhd,bqkd->bqhk', q_b, kv_sel).astype(jnp.float32) * ATTN_SCALE
        dist = jnp.abs(t_b[None, :, None] - sel).astype(jnp.float32)
        logits = logits - slopes[None, None, :, None] * dist[:, :, None, :]
        valid = sel < limit[None, :, None]
        logits = jnp.where(valid[:, :, None, :], logits, NEG_INF)
        probs = jax.nn.softmax(logits, axis=-1).astype(kv_sel.dtype)
        return jnp.einsum('bqhk,bqkd->bqhd', probs, kv_sel)

    pos = jnp.arange(S, dtype=jnp.int32).reshape(nb, QBLOCK)
    o = lax.map(attend, (to_blocks(q), to_blocks(qi), to_blocks(widx), pos))
    o = jnp.moveaxis(o, 0, 1).reshape(Bsz, S, N_HEADS, D_LAT)
    return jnp.einsum('bshd,hde->bshe', o, w_uv).reshape(Bsz, S, W_ATTN)


def _ssm_combine(left, right):
    a_l, b_l = left
    a_r, b_r = right
    return (a_r * a_l, a_r * b_l + b_r)


def _s5_branch(u, a_re, a_im, b_re, b_im, c_re, c_im, d_skip, log_step, w_glu, b_glu):
    Bsz, S, _ = u.shape
    f32 = jnp.float32
    uf = u.astype(f32).reshape(Bsz, S, SSM_GROUPS, SSM_GROUP_DIM)
    lam = lax.complex(a_re.astype(f32), a_im.astype(f32))
    step = jnp.exp(log_step.astype(f32))[:, None]
    lam_bar = jnp.exp(lam * step)
    b_mat = lax.complex(b_re.astype(f32), b_im.astype(f32))
    b_bar = ((lam_bar - 1.0) / lam)[:, :, None] * b_mat
    bu = jnp.einsum('bsgp,gnp->bsgn', uf, b_bar)
    a_seq = jnp.broadcast_to(lam_bar, (1, S, SSM_GROUPS, SSM_STATE))
    _, states = lax.associative_scan(_ssm_combine, (a_seq, bu), axis=1)
    c_mat = lax.complex(c_re.astype(f32), c_im.astype(f32))
    y = jnp.real(jnp.einsum('bsgn,gpn->bsgp', states, c_mat))
    y = y + d_skip.astype(f32).reshape(SSM_GROUPS, SSM_GROUP_DIM) * uf
    z = jax.nn.gelu(y.reshape(Bsz, S, W_SSM))
    out = z * jax.nn.sigmoid(z @ w_glu.astype(f32) + b_glu.astype(f32))
    return out.astype(u.dtype)


def _pool_branch(u, w_pool, pool_scale):
    Bsz, S, _ = u.shape
    f32 = jnp.float32
    uf = u.astype(f32).reshape(Bsz, S, POOL_GROUPS, POOL_GROUP_DIM)
    csum = jnp.pad(jnp.cumsum(uf, axis=1), ((0, 0), (1, 0), (0, 0), (0, 0)))
    t = jnp.arange(S)
    means = []
    for g, win in enumerate(POOL_WINDOWS):
        cs_g = csum[:, :, g]
        lo = jnp.maximum(t + 1 - win, 0)
        count = jnp.minimum(t + 1, win).astype(f32)[None, :, None]
        means.append((cs_g[:, 1:] - cs_g[:, lo]) / count)
    pooled = jnp.stack(means, axis=2) - uf
    y = jnp.einsum('bsgc,gcd->bsgd', pooled, w_pool.astype(f32))
    y = y * pool_scale.astype(f32).reshape(POOL_GROUPS, POOL_GROUP_DIM)
    return y.reshape(Bsz, S, W_POOL).astype(u.dtype)


def _token_mixer(h, w_in, g_cq, w_uq, w_qi, g_ckv, w_uv, a_re, a_im, b_re, b_im, c_re, c_im,
                 d_skip, log_step, w_glu, b_glu, w_pool, pool_scale, p_a, p_b, p_c, w_out):
    Bsz, S, _ = h.shape
    z = h @ w_in
    splits = [int(v) for v in np.cumsum(IN_SPLITS)[:-1]]
    cq, ckv, kidx, widx, u_ssm, u_pool, gate_logits = jnp.split(z, splits, axis=-1)
    y_attn = _dsa_branch(cq, ckv, kidx, widx, g_cq, w_uq, w_qi, g_ckv, w_uv)
    y_ssm = _s5_branch(u_ssm, a_re, a_im, b_re, b_im, c_re, c_im, d_skip, log_step, w_glu, b_glu)
    y_pool = _pool_branch(u_pool, w_pool, pool_scale)
    gates = jax.nn.sigmoid(gate_logits).reshape(Bsz, S, N_BRANCH, D_MODEL)
    merged = (gates[:, :, 0] * (y_attn @ p_a)
              + gates[:, :, 1] * (y_ssm @ p_b)
              + gates[:, :, 2] * (y_pool @ p_c))
    return merged @ w_out


def _conv_gated_ffn(h, w_up, conv_w, conv_b, w_down):
    S = h.shape[1]
    u = h @ w_up
    up = jnp.pad(u, ((0, 0), (CONV_WIDTH - 1, 0), (0, 0)))
    acc = conv_b + conv_w[0] * up[:, 0:S]
    for k in range(1, CONV_WIDTH):
        acc = acc + conv_w[k] * up[:, k:k + S]
    g, v = jnp.split(acc, 2, axis=-1)
    return (jax.nn.gelu(g) * v) @ w_down


def setup_inputs(seed: int = 0) -> dict:
    key = jax.random.key(seed)
    ks = iter(jax.random.split(key, 40))
    f32 = jnp.float32
    L = DEPTH

    def nrm(shape, scale):
        return jax.random.normal(next(ks), shape, f32) * scale

    def gain(shape):
        return 1.0 + nrm(shape, 0.02)

    n_idx = jnp.arange(SSM_STATE, dtype=f32)
    return {
        'x': nrm((BATCH, SEQ, D_MODEL), 1.0),
        'c': nrm((BATCH, D_MODEL), 1.0),
        'mod_w': nrm((L, D_MODEL, 6 * D_MODEL), 0.5 * D_MODEL ** -0.5),
        'mod_b': nrm((L, 6 * D_MODEL), 0.02),
        'mix_pre_g': gain((L, D_MODEL)),
        'mix_post_g': gain((L, D_MODEL)),
        'ffn_pre_g': gain((L, D_MODEL)),
        'ffn_post_g': gain((L, D_MODEL)),
        'w_in': nrm((L, D_MODEL, N_IN), D_MODEL ** -0.5),
        'g_cq': gain((L, D_QLAT)),
        'w_uq': nrm((L, D_QLAT, N_HEADS, D_LAT), D_QLAT ** -0.5),
        'w_qi': nrm((L, D_QLAT, IDX_HEADS, IDX_DIM), D_QLAT ** -0.5),
        'g_ckv': gain((L, D_LAT)),
        'w_uv': nrm((L, N_HEADS, D_LAT, D_VHEAD), D_LAT ** -0.5),
        'a_re': -0.5 + nrm((L, SSM_GROUPS, SSM_STATE), 0.01),
        'a_im': math.pi * n_idx + nrm((L, SSM_GROUPS, SSM_STATE), 0.01),
        'b_re': nrm((L, SSM_GROUPS, SSM_STATE, SSM_GROUP_DIM), (2 * SSM_GROUP_DIM) ** -0.5),
        'b_im': nrm((L, SSM_GROUPS, SSM_STATE, SSM_GROUP_DIM), (2 * SSM_GROUP_DIM) ** -0.5),
        'c_re': nrm((L, SSM_GROUPS, SSM_GROUP_DIM, SSM_STATE), (2 * SSM_STATE) ** -0.5 * 4.0),
        'c_im': nrm((L, SSM_GROUPS, SSM_GROUP_DIM, SSM_STATE), (2 * SSM_STATE) ** -0.5 * 4.0),
        'd_skip': nrm((L, W_SSM), 1.0),
        'log_step': jax.random.uniform(next(ks), (L, SSM_GROUPS), f32, math.log(1e-3), math.log(1e-1)),
        'w_glu': nrm((L, W_SSM, W_SSM), W_SSM ** -0.5),
        'b_glu': nrm((L, W_SSM), 0.01),
        'w_pool': nrm((L, POOL_GROUPS, POOL_GROUP_DIM, POOL_GROUP_DIM), POOL_GROUP_DIM ** -0.5),
        'pool_scale': 1.0 + nrm((L, W_POOL), 0.1),
        'p_a': nrm((L, W_ATTN, D_MODEL), W_ATTN ** -0.5),
        'p_b': nrm((L, W_SSM, D_MODEL), W_SSM ** -0.5),
        'p_c': nrm((L, W_POOL, D_MODEL), W_POOL ** -0.5),
        'w_out': nrm((L, D_MODEL, D_MODEL), D_MODEL ** -0.5),
        'w_up': nrm((L, D_MODEL, 2 * D_FF), D_MODEL ** -0.5),
        'conv_w': nrm((L, CONV_WIDTH, 2 * D_FF), CONV_WIDTH ** -0.5),
        'conv_b': nrm((L, 2 * D_FF), 0.01),
        'w_down': nrm((L, D_FF, D_MODEL), D_FF ** -0.5),
    }


def reference(x, c, mod_w, mod_b, mix_pre_g, mix_post_g, ffn_pre_g, ffn_post_g, w_in,
              g_cq, w_uq, w_qi, g_ckv, w_uv, a_re, a_im, b_re, b_im, c_re, c_im, d_skip,
              log_step, w_glu, b_glu, w_pool, pool_scale, p_a, p_b, p_c, w_out,
              w_up, conv_w, conv_b, w_down):
    cond = jax.nn.silu(c)
    for l in range(DEPTH):
        mod = (cond @ mod_w[l] + mod_b[l])[:, None, :]
        sh_m, sc_m, gt_m, sh_f, sc_f, gt_f = jnp.split(mod, 6, axis=-1)
        h = _rmsnorm(x, mix_pre_g[l]) * (1.0 + sc_m) + sh_m
        y = _token_mixer(h, w_in[l], g_cq[l], w_uq[l], w_qi[l], g_ckv[l], w_uv[l],
                         a_re[l], a_im[l], b_re[l], b_im[l], c_re[l], c_im[l], d_skip[l],
                         log_step[l], w_glu[l], b_glu[l], w_pool[l], pool_scale[l],
                         p_a[l], p_b[l], p_c[l], w_out[l])
        x = x + gt_m * _rmsnorm(y, mix_post_g[l])
        h = _rmsnorm(x, ffn_pre_g[l]) * (1.0 + sc_f) + sh_f
        y = _conv_gated_ffn(h, w_up[l], conv_w[l], conv_b[l], w_down[l])
        x = x + gt_f * _rmsnorm(y, ffn_post_g[l])
    return x
```

```cpp
#include <hip/hip_runtime.h>
#include <cstdio>
#include <cstdint>
namespace pg8 {
#define PG8_LAS __attribute__((address_space(3)))
typedef unsigned short bf16_t;
typedef short bf16x8 __attribute__((ext_vector_type(8)));
typedef float f32x4 __attribute__((ext_vector_type(4)));
typedef unsigned u32x4 __attribute__((ext_vector_type(4)));
constexpr int BM = 256, BK = 64, HALF = 128, HTB = HALF * BK * 2  , STAGE_BYTES = 8 * HTB, NXCD = 8, WGM = 8;

__host__ __device__ __forceinline__ int lds_byte(int r, int c) { const int st = (r >> 4) * 2 + (c >> 5), rr = r & 15, cc = c & 31, ob = rr * 64 + cc * 2; return st * 1024 + (ob ^ (((ob >> 9) & 1) << 5)); }
__host__ __device__ __forceinline__ void stage_rc(int b, int& R, int& C) { const int st = b / 1024, sb = b % 1024, swz = sb ^ (((sb >> 9) & 1) << 5); R = (st >> 1) * 16 + swz / 64; C = (st & 1) * 32 + (swz % 64) / 2; }
__host__ __device__ __forceinline__ int perm32(int rho) { const int n = rho >> 4, i = rho & 15; return 8 * (i >> 2) + 4 * n + (i & 3); }

struct Unit { int pm, pn; };
struct Gemm { const bf16_t* A; const bf16_t* Bt; int M, N, K, lda, ldb; };

struct StaticOrder {
    int nM, nN, nwg, G, c;
    __host__ __device__ void init(int M, int N, int G_, int c_) { nM = M / BM; nN = N / BM; nwg = nM * nN; G = G_; c = c_; }
    __host__ __device__ bool next(int i, Unit& u) const {
        const long L = (long)i * G + c; if (L >= nwg) return false;
        int wgid = (int)L; { const int q = nwg / NXCD, r = nwg % NXCD, xcd = wgid % NXCD, off = wgid / NXCD; wgid = (xcd < r ? xcd * (q + 1) : r * (q + 1) + (xcd - r) * q) + off; }
        const int nig = WGM * nN, gid = wgid / nig, fm = gid * WGM, gsz = (nM - fm) < WGM ? (nM - fm) : WGM;
        u.pm = fm + ((wgid % nig) % gsz); u.pn = (wgid % nig) / gsz; return true;
    }
    __device__ __forceinline__ void a_ready(const Unit&) const {}
    __device__ __forceinline__ void done(const Unit&) const {}
};

__device__ __forceinline__ unsigned cvt_pk_bf16(float lo, float hi) { unsigned r; asm volatile("v_cvt_pk_bf16_f32 %0, %1, %2" : "=v"(r) : "v"(lo), "v"(hi)); return r; }
typedef float f32x2 __attribute__((ext_vector_type(2)));
__device__ __forceinline__ f32x2 gelu_pk(f32x2 v) {
    const f32x2 av = __builtin_elementwise_abs(v), d = av * 0.2316418882f + 1.0f;
    f32x2 t; t.x = __builtin_amdgcn_rcpf(d.x); t.y = __builtin_amdgcn_rcpf(d.y);
    f32x2 q = t * 0.5307027145f + (-0.7265760135f); q = q * t + 0.7107068705f; q = q * t + (-0.142248368f); q = q * t + 0.127414796f; q = q * t;
    const f32x2 s = (v * v) * (-0.72134752044f);
    f32x2 e; e.x = __builtin_amdgcn_exp2f(s.x); e.y = __builtin_amdgcn_exp2f(s.y);
    const f32x2 m = v * (q * e), r = v - m;
    f32x2 o; o.x = v.x < 0.f ? m.x : r.x; o.y = v.y < 0.f ? m.y : r.y; return o;
}

template <int ACT  > struct EpiBf16 {
    static constexpr bool PERM = true, AFTER_DRAIN = false; static_assert(ACT == 0 || ACT == 1, "EpiBf16: ACT is 0 (none) or 1 (gelu_pk)");
    bf16_t* O; int ldc; const float* bias; int split_cols; size_t split_stride; float scale0;
    __device__ __forceinline__ void operator()(const f32x4 (&acc)[2][2][4][2], const Unit& u, int wr, int wc, int fr, int fq) const {
        const int row0 = u.pm * BM + wr * 64 + fr; int colt = u.pn * BM; bf16_t* base = O;
        float sc = 1.f; if (split_cols) { const int t = colt / split_cols; base += (size_t)t * split_stride; colt -= t * split_cols; if (t == 0) sc = scale0; }
        const int col0 = colt + wc * 32 + 8 * fq, bcol0 = u.pn * BM + wc * 32 + 8 * fq;
        f32x4 bv[2][2];
#pragma unroll
        for (int bj = 0; bj < 2; ++bj)
#pragma unroll
            for (int n = 0; n < 2; ++n) bv[bj][n] = bias ? *(const f32x4*)(bias + bcol0 + bj * HALF + 4 * n) : (f32x4){0.f, 0.f, 0.f, 0.f};
#pragma unroll
        for (int ai = 0; ai < 2; ++ai)
#pragma unroll
            for (int m = 0; m < 4; ++m) { bf16_t* rowp = base + (size_t)(row0 + ai * HALF + m * 16) * ldc + col0;
#pragma unroll
                for (int bj = 0; bj < 2; ++bj) { f32x4 v0 = acc[ai][bj][m][0] + bv[bj][0], v1 = acc[ai][bj][m][1] + bv[bj][1];
                    if (ACT == 1) { f32x2 a = gelu_pk((f32x2){v0[0], v0[1]}), b = gelu_pk((f32x2){v0[2], v0[3]}), c = gelu_pk((f32x2){v1[0], v1[1]}), d = gelu_pk((f32x2){v1[2], v1[3]});
                        v0 = (f32x4){a.x, a.y, b.x, b.y}; v1 = (f32x4){c.x, c.y, d.x, d.y}; }
                    v0 = v0 * sc; v1 = v1 * sc; u32x4 w; w.x = cvt_pk_bf16(v0[0], v0[1]); w.y = cvt_pk_bf16(v0[2], v0[3]); w.z = cvt_pk_bf16(v1[0], v1[1]); w.w = cvt_pk_bf16(v1[2], v1[3]);
                    *(u32x4*)(rowp + bj * HALF) = w; } }
    }
};

__device__ __forceinline__ float bf_lo(unsigned w) { return __uint_as_float(w << 16); }
__device__ __forceinline__ float bf_hi(unsigned w) { return __uint_as_float(w & 0xffff0000u); }
__device__ __forceinline__ float sigmoidf_(float x) { return __builtin_amdgcn_rcpf(1.0f + __builtin_amdgcn_exp2f(-1.4426950408889634f * x)); }
__device__ __forceinline__ float gelu_tanh(float x) { const float u = x * (1.5957691216057308f + 0.07135481627f * x * x); return x * sigmoidf_(u); }

struct EpiE {
    static constexpr bool PERM = false, AFTER_DRAIN = false;
    float* C;
    __device__ __forceinline__ void operator()(const f32x4 (&acc)[2][2][4][2], const Unit& u, int wr, int wc, int fr, int fq) const {
        const int row0 = u.pm * BM + wr * 64 + fr, col0 = wc * 32 + 4 * fq;
#pragma unroll
        for (int ai = 0; ai < 2; ++ai)
#pragma unroll
            for (int m = 0; m < 4; ++m) { float* rowp = C + (size_t)(row0 + ai * HALF + m * 16) * 128 + col0;
#pragma unroll
                for (int n = 0; n < 2; ++n) *(f32x4*)(rowp + n * 16) = acc[ai][0][m][n]; }
    }
};
struct EpiS5Y {
    static constexpr bool PERM = true, AFTER_DRAIN = false;
    bf16_t* ZS;
    __device__ __forceinline__ void operator()(const f32x4 (&acc)[2][2][4][2], const Unit& u, int wr, int wc, int fr, int fq) const {
        const int g = u.pm >> 2, i = u.pm & 3, j = u.pn & 3;
        bf16_t* base = ZS + ((size_t)(256 * i + 64 * wr + fr) * 64 + (16 * j + 2 * wc + (fq >> 1))) * 256 + 16 * g + 8 * (fq & 1);
#pragma unroll
        for (int ai = 0; ai < 2; ++ai)
#pragma unroll
            for (int m = 0; m < 4; ++m) {
#pragma unroll
                for (int bj = 0; bj < 2; ++bj) {
                    const f32x4 v0 = acc[ai][bj][m][0], v1 = acc[ai][bj][m][1];
                    u32x4 w; w.x = cvt_pk_bf16(gelu_tanh(v0[0]), gelu_tanh(v0[1])); w.y = cvt_pk_bf16(gelu_tanh(v0[2]), gelu_tanh(v0[3]));
                    w.z = cvt_pk_bf16(gelu_tanh(v1[0]), gelu_tanh(v1[1])); w.w = cvt_pk_bf16(gelu_tanh(v1[2]), gelu_tanh(v1[3]));
                    *(u32x4*)(base + (size_t)((ai * HALF + m * 16) * 64 + bj * 8) * 256) = w; }
                asm volatile("" ::: "memory"); }
    }
};
struct EpiGlu {
    static constexpr bool PERM = true, AFTER_DRAIN = false;
    const bf16_t* Zin; bf16_t* O; const float* bias;
    __device__ __forceinline__ void operator()(const f32x4 (&acc)[2][2][4][2], const Unit& u, int wr, int wc, int fr, int fq) const {
        const int row0 = u.pm * BM + wr * 64 + fr, col0 = u.pn * BM + wc * 32 + 8 * fq;
#pragma unroll
        for (int bj = 0; bj < 2; ++bj) { const f32x4 b0 = *(const f32x4*)(bias + col0 + bj * HALF), b1 = *(const f32x4*)(bias + col0 + bj * HALF + 4);
#pragma unroll
            for (int ai = 0; ai < 2; ++ai)
#pragma unroll
                for (int m = 0; m < 4; ++m) { const size_t off = (size_t)(row0 + ai * HALF + m * 16) * 256 + col0 + bj * HALF;
                    const u32x4 z = *(const u32x4*)(Zin + off); const f32x4 v0 = acc[ai][bj][m][0] + b0, v1 = acc[ai][bj][m][1] + b1;
                    u32x4 w; w.x = cvt_pk_bf16(bf_lo(z.x) * sigmoidf_(v0[0]), bf_hi(z.x) * sigmoidf_(v0[1])); w.y = cvt_pk_bf16(bf_lo(z.y) * sigmoidf_(v0[2]), bf_hi(z.y) * sigmoidf_(v0[3]));
                    w.z = cvt_pk_bf16(bf_lo(z.z) * sigmoidf_(v1[0]), bf_hi(z.z) * sigmoidf_(v1[1])); w.w = cvt_pk_bf16(bf_lo(z.w) * sigmoidf_(v1[2]), bf_hi(z.w) * sigmoidf_(v1[3]));
                    *(u32x4*)(O + off) = w; } }
    }
};
template <bool ACCUM> struct EpiGate {
    static constexpr bool PERM = true, AFTER_DRAIN = false;
    const bf16_t* G; bf16_t* O;
    __device__ __forceinline__ void operator()(const f32x4 (&acc)[2][2][4][2], const Unit& u, int wr, int wc, int fr, int fq) const {
        const int row0 = u.pm * BM + wr * 64 + fr, col0 = u.pn * BM + wc * 32 + 8 * fq;
#pragma unroll
        for (int ai = 0; ai < 2; ++ai)
#pragma unroll
            for (int m = 0; m < 4; ++m)
#pragma unroll
                for (int bj = 0; bj < 2; ++bj) { const size_t off = (size_t)(row0 + ai * HALF + m * 16) * 1024 + col0 + bj * HALF;
                    const u32x4 gl = *(const u32x4*)(G + off); const f32x4 v0 = acc[ai][bj][m][0], v1 = acc[ai][bj][m][1];
                    float o[8] = {sigmoidf_(bf_lo(gl.x)) * v0[0], sigmoidf_(bf_hi(gl.x)) * v0[1], sigmoidf_(bf_lo(gl.y)) * v0[2], sigmoidf_(bf_hi(gl.y)) * v0[3],
                                  sigmoidf_(bf_lo(gl.z)) * v1[0], sigmoidf_(bf_hi(gl.z)) * v1[1], sigmoidf_(bf_lo(gl.w)) * v1[2], sigmoidf_(bf_hi(gl.w)) * v1[3]};
                    if (ACCUM) { const u32x4 pv = *(const u32x4*)(O + off);
                        o[0] += bf_lo(pv.x); o[1] += bf_hi(pv.x); o[2] += bf_lo(pv.y); o[3] += bf_hi(pv.y); o[4] += bf_lo(pv.z); o[5] += bf_hi(pv.z); o[6] += bf_lo(pv.w); o[7] += bf_hi(pv.w); }
                    u32x4 w; w.x = cvt_pk_bf16(o[0], o[1]); w.y = cvt_pk_bf16(o[2], o[3]); w.z = cvt_pk_bf16(o[4], o[5]); w.w = cvt_pk_bf16(o[6], o[7]);
                    *(u32x4*)(O + off) = w; }
    }
};
template <int NJ> struct GroupOrder {
    int G, c;
    __device__ __forceinline__ bool next(int i, Unit& u) const { const int L = i * G + c; if (L >= 16 * 4 * NJ) return false; const int g = L / (4 * NJ), r = L % (4 * NJ); u.pm = 4 * g + r / NJ; u.pn = NJ * g + r % NJ; return true; }
    __device__ __forceinline__ void a_ready(const Unit&) const {}
    __device__ __forceinline__ void done(const Unit&) const {}
};
template <class Epi, class Sched, bool ALIGN_EPI = false, bool SP2 = false>
__device__ __forceinline__ void gemm_phase(PG8_LAS unsigned char* lds, const Gemm g, const Sched& S, const Epi& E, const int wave_in) {
    int lane_; asm volatile("v_mbcnt_lo_u32_b32 %0, -1, 0\n\tv_mbcnt_hi_u32_b32 %0, -1, %0" : "=v"(lane_));
    const int wid = wave_in, lane = lane_, tid = wid * 64 + lane, wr = wid >> 2, wc = wid & 3, fr = lane & 15, fq = lane >> 4;
    const int K = g.K, nt = K / BK, lda = g.lda, ldb = g.ldb;
    unsigned voffA[2], voffB[2];
#pragma unroll
    for (int i = 0; i < 2; ++i) { int R, C; stage_rc(tid * 16 + i * 8192, R, C); const int Rb = Epi::PERM ? ((R & ~31) + perm32(R & 31)) : R;
        voffA[i] = (unsigned)(R * lda + C) * 2u; voffB[i] = (unsigned)(Rb * ldb + C) * 2u; }
    const size_t kstep = (size_t)(BK * 2);
    const size_t hstepA = (size_t)HALF * lda * 2, hstepB = (size_t)HALF * ldb * 2;
    const size_t tstepA = 2 * hstepA, tstepB = 2 * hstepB;
    const unsigned ldsw = (unsigned)wid * 1024u;
    const int aoff = lds_byte(wr * 64 + fr, fq * 8), boff = lds_byte(wc * 32 + fr, fq * 8);
#define PG8_SA(b, h) (((b) * 2 + (h)) * HTB)
#define PG8_SB(b, h) ((4 + (b) * 2 + (h)) * HTB)
#define PG8_STAGE(bufoff, gbase, voff) do { _Pragma("unroll") for (int _i = 0; _i < 2; ++_i) \
        __builtin_amdgcn_global_load_lds((const unsigned*)((const char*)(gbase) + (voff)[_i]), (PG8_LAS unsigned*)(lds + (bufoff) + ldsw + _i * 8192), 16, 0, 0); } while (0)
#define PG8_LDA(dst, b, h) do { _Pragma("unroll") for (int m = 0; m < 4; ++m) _Pragma("unroll") for (int k = 0; k < 2; ++k) dst[m][k] = *(const PG8_LAS bf16x8*)(lds + PG8_SA(b, h) + aoff + m * 2048 + k * 1024); } while (0)
#define PG8_LDB(dst, b, h) do { _Pragma("unroll") for (int n = 0; n < 2; ++n) _Pragma("unroll") for (int k = 0; k < 2; ++k) dst[n][k] = *(const PG8_LAS bf16x8*)(lds + PG8_SB(b, h) + boff + n * 2048 + k * 1024); } while (0)
#define PG8_MMA(ai, bj, At, Bt) do { __builtin_amdgcn_s_setprio(1); _Pragma("unroll") for (int m = 0; m < 4; ++m) _Pragma("unroll") for (int n = 0; n < 2; ++n) _Pragma("unroll") for (int k = 0; k < 2; ++k) \
        acc[ai][bj][m][n] = __builtin_amdgcn_mfma_f32_16x16x32_bf16(Bt[n][k], At[m][k], acc[ai][bj][m][n], 0, 0, 0); __builtin_amdgcn_s_setprio(0); } while (0)
#define PG8_WAIT_V(n) asm volatile("s_waitcnt vmcnt(" #n ")" ::: "memory")
#define PG8_WAIT_L(n) asm volatile("s_waitcnt lgkmcnt(" #n ")" ::: "memory")
#define PG8_BAR __builtin_amdgcn_s_barrier()
#define PG8_SCHED __builtin_amdgcn_sched_barrier(0)
    Unit cur, nxt; int ui = 0;
    if (!S.next(0, cur)) return;
    f32x4 acc[2][2][4][2];
#pragma unroll
    for (int a = 0; a < 2; ++a)
#pragma unroll
        for (int b = 0; b < 2; ++b)
#pragma unroll
            for (int m = 0; m < 4; ++m)
#pragma unroll
                for (int n = 0; n < 2; ++n) acc[a][b][m][n] = (f32x4){0.f, 0.f, 0.f, 0.f};
    bf16x8 At[4][2], B0[2][2], B1[2][2];
    const char* cA = (const char*)g.A + (size_t)cur.pm * tstepA; const char* cB = (const char*)g.Bt + (size_t)cur.pn * tstepB;
    S.a_ready(cur);
    if constexpr (SP2) {
        PG8_STAGE(PG8_SB(0, 0), cB, voffB); PG8_STAGE(PG8_SB(0, 1), cB + hstepB, voffB); PG8_STAGE(PG8_SA(0, 0), cA, voffA); PG8_STAGE(PG8_SA(0, 1), cA + hstepA, voffA);
        if (wr == 1) PG8_BAR;
        PG8_WAIT_V(2); PG8_BAR;
        PG8_STAGE(PG8_SB(1, 0), cB + kstep, voffB); PG8_STAGE(PG8_SA(1, 0), cA + kstep, voffA); PG8_STAGE(PG8_SB(1, 1), cB + hstepB + kstep, voffB);
        PG8_WAIT_V(6); PG8_BAR;
    } else {
        PG8_STAGE(PG8_SB(0, 0), cB, voffB); PG8_STAGE(PG8_SA(0, 0), cA, voffA); PG8_STAGE(PG8_SB(0, 1), cB + hstepB, voffB); PG8_STAGE(PG8_SA(0, 1), cA + hstepA, voffA);
        if (wr == 1) PG8_BAR;
        PG8_WAIT_V(4); PG8_BAR;
        PG8_STAGE(PG8_SB(1, 0), cB + kstep, voffB); PG8_STAGE(PG8_SA(1, 0), cA + kstep, voffA); PG8_STAGE(PG8_SB(1, 1), cB + hstepB + kstep, voffB);
        PG8_WAIT_V(6); PG8_BAR;
    }
    for (;;) {
        const bool has_next = S.next(ui + 1, nxt);
        const char* nA = has_next ? (const char*)g.A + (size_t)nxt.pm * tstepA : cA; const char* nB = has_next ? (const char*)g.Bt + (size_t)nxt.pn * tstepB : cB;
#pragma nounroll
        for (int t = 0; t < nt; t += 2) {
            const bool last = (t == nt - 2);
            const char* a1 = cA + (size_t)(t + 1) * kstep;
            const char* a2 = last ? nA : cA + (size_t)(t + 2) * kstep; const char* b2 = last ? nB : cB + (size_t)(t + 2) * kstep;
            const char* a3 = a2 + kstep; const char* b3 = b2 + kstep;
            if (last && has_next) S.a_ready(nxt);
            if constexpr (SP2) {
            PG8_LDB(B0, 0, 0); PG8_LDB(B1, 0, 1); PG8_SCHED; PG8_LDA(At, 0, 0); PG8_STAGE(PG8_SA(1, 1), a1 + hstepA, voffA);
            PG8_WAIT_V(8); PG8_WAIT_L(0); PG8_BAR; PG8_MMA(0, 0, At, B0); PG8_MMA(0, 1, At, B1); PG8_BAR; PG8_SCHED;
            PG8_LDA(At, 0, 1); PG8_STAGE(PG8_SB(0, 0), b2, voffB); PG8_STAGE(PG8_SB(0, 1), b2 + hstepB, voffB); PG8_STAGE(PG8_SA(0, 0), a2, voffA);
            PG8_WAIT_V(8); PG8_WAIT_L(0); PG8_BAR; PG8_MMA(1, 0, At, B0); PG8_MMA(1, 1, At, B1); PG8_BAR; PG8_SCHED;
            PG8_LDB(B0, 1, 0); PG8_LDB(B1, 1, 1); PG8_SCHED; PG8_LDA(At, 1, 0); PG8_STAGE(PG8_SA(0, 1), a2 + hstepA, voffA);
            PG8_WAIT_V(8); PG8_WAIT_L(0); PG8_BAR; PG8_MMA(0, 0, At, B0); PG8_MMA(0, 1, At, B1); PG8_BAR; PG8_SCHED;
            PG8_LDA(At, 1, 1); PG8_STAGE(PG8_SB(1, 0), b3, voffB); PG8_STAGE(PG8_SB(1, 1), b3 + hstepB, voffB); PG8_STAGE(PG8_SA(1, 0), a3, voffA);
            PG8_WAIT_V(8); PG8_WAIT_L(0); PG8_BAR; PG8_MMA(1, 0, At, B0); PG8_MMA(1, 1, At, B1); PG8_BAR; PG8_SCHED;
            } else {
            PG8_LDB(B0, 0, 0); PG8_SCHED; PG8_LDA(At, 0, 0); PG8_STAGE(PG8_SA(1, 1), a1 + hstepA, voffA);
            PG8_WAIT_L(8); PG8_BAR; PG8_WAIT_L(0); PG8_MMA(0, 0, At, B0); PG8_BAR; PG8_SCHED;
            PG8_LDB(B1, 0, 1); PG8_STAGE(PG8_SB(0, 0), b2, voffB);
            PG8_BAR; PG8_WAIT_L(0); PG8_MMA(0, 1, At, B1); PG8_BAR;
            PG8_LDA(At, 0, 1); PG8_STAGE(PG8_SA(0, 0), a2, voffA);
            PG8_BAR; PG8_WAIT_L(0); PG8_MMA(1, 0, At, B0); PG8_BAR; PG8_SCHED;
            PG8_STAGE(PG8_SB(0, 1), b2 + hstepB, voffB);
            PG8_WAIT_V(6); PG8_BAR; PG8_MMA(1, 1, At, B1); PG8_BAR;
            PG8_LDB(B0, 1, 0); PG8_SCHED; PG8_LDA(At, 1, 0); PG8_STAGE(PG8_SA(0, 1), a2 + hstepA, voffA);
            PG8_WAIT_L(8); PG8_BAR; PG8_WAIT_L(0); PG8_MMA(0, 0, At, B0); PG8_BAR; PG8_SCHED;
            PG8_LDB(B1, 1, 1); PG8_STAGE(PG8_SB(1, 0), b3, voffB);
            PG8_BAR; PG8_WAIT_L(0); PG8_MMA(0, 1, At, B1); PG8_BAR;
            PG8_LDA(At, 1, 1); PG8_STAGE(PG8_SA(1, 0), a3, voffA);
            PG8_BAR; PG8_WAIT_L(0); PG8_MMA(1, 0, At, B0); PG8_BAR; PG8_SCHED;
            PG8_STAGE(PG8_SB(1, 1), b3 + hstepB, voffB);
            PG8_WAIT_V(6); PG8_BAR; PG8_MMA(1, 1, At, B1); PG8_BAR;
            }
        }
        if constexpr (ALIGN_EPI) { if (wr == 0) PG8_BAR; }
        if constexpr (!Epi::AFTER_DRAIN) { E(acc, cur, wr, wc, fr, fq); S.done(cur); }
        if (!has_next) break;
#pragma unroll
        for (int a = 0; a < 2; ++a)
#pragma unroll
            for (int b = 0; b < 2; ++b)
#pragma unroll
                for (int m = 0; m < 4; ++m)
#pragma unroll
                    for (int n = 0; n < 2; ++n) acc[a][b][m][n] = (f32x4){0.f, 0.f, 0.f, 0.f};
        cur = nxt; cA = nA; cB = nB; ++ui;
        if constexpr (ALIGN_EPI) { if (wr == 1) PG8_BAR; }
    }
    PG8_WAIT_V(0);
    if constexpr (!ALIGN_EPI) { if (wr == 0) PG8_BAR; }
    PG8_BAR;
    if constexpr (Epi::AFTER_DRAIN) { E.fused(acc, cur, wr, wc, fr, fq, lds, wid, lane); S.done(cur); }
#undef PG8_SA
#undef PG8_SB
#undef PG8_STAGE
#undef PG8_LDA
#undef PG8_LDB
#undef PG8_MMA
#undef PG8_WAIT_V
#undef PG8_WAIT_L
#undef PG8_BAR
#undef PG8_SCHED
}
}
#define GAS __attribute__((address_space(1)))
#define LAS __attribute__((address_space(3)))
typedef unsigned short bf16;
typedef unsigned v4u __attribute__((ext_vector_type(4)));
typedef float f32x4 __attribute__((ext_vector_type(4)));
typedef short bf16x8 __attribute__((ext_vector_type(8)));
typedef GAS unsigned gu32;
typedef GAS unsigned long long gu64;
#define RLX_AGENT __ATOMIC_RELAXED, __HIP_MEMORY_SCOPE_AGENT
#define LDS_WAIT() asm volatile("s_waitcnt lgkmcnt(0)" ::: "memory")
#define VM_WAIT() asm volatile("s_waitcnt vmcnt(0)" ::: "memory")
__device__ __forceinline__ unsigned long long rt() { return __builtin_amdgcn_s_memrealtime(); }
__device__ __forceinline__ unsigned f2bf(float f) { unsigned u = __builtin_bit_cast(unsigned, f); return (u + 0x7fffu + ((u >> 16) & 1u)) >> 16; }
__device__ __forceinline__ unsigned pk2(float lo, float hi) { return f2bf(lo) | (f2bf(hi) << 16); }

#define XB_TMO      128
#define XB_XCNT(j)  (256  + 64 * (j))
#define XB_XSUB(j)  (1280 + 64 * (j))
#define XB_XGEN(j)  (2304 + 64 * (j))
#define XB_TOP      3328
#define XB_TOPGEN   3392
#define XCD_BAR_WORDS 3456
#define XB_SPIN_CAP (1u << 18)

__device__ __forceinline__ unsigned xb_ld(unsigned* p)              { return __hip_atomic_load(p, __ATOMIC_RELAXED, __HIP_MEMORY_SCOPE_AGENT); }
__device__ __forceinline__ unsigned xb_add(unsigned* p, unsigned v) { return __hip_atomic_fetch_add(p, v, __ATOMIC_RELAXED, __HIP_MEMORY_SCOPE_AGENT); }
__device__ __forceinline__ unsigned xb_xcc_id() { return (unsigned)__builtin_amdgcn_s_getreg((3 << 11) | 20) & 0xFu; }
#define XB_SPIN(cond, bar) do { unsigned _sp = 0; while (cond) { __builtin_amdgcn_s_sleep(1); \
    if ((++_sp & 255u) == 0u) { if (xb_ld(&(bar)[XB_TMO])) break; if (_sp > XB_SPIN_CAP) { atomicAdd(&(bar)[XB_TMO], 1u); break; } } } } while (0)

struct XcdBarrier {
    unsigned* bar; unsigned x;
    volatile LAS unsigned* st;
};

__device__ __forceinline__ XcdBarrier xcd_barrier_post(unsigned* bar, volatile LAS unsigned* st) {
    XcdBarrier b; b.bar = bar; b.x = xb_xcc_id(); b.st = st;
    if (threadIdx.x == 0) (void)xb_add(&bar[XB_XCNT(b.x)], 1u);
    return b;
}
__device__ __forceinline__ void xcd_barrier_complete(unsigned* bar, unsigned x, unsigned& nloc, unsigned& nx) {
    const unsigned G = gridDim.x * gridDim.y * gridDim.z;
    unsigned sum, cnt, mine, sp = 0u;
    for (;;) {
        sum = 0u; cnt = 0u; mine = 0u;
#pragma unroll
        for (unsigned j = 0; j < 16; ++j) { const unsigned c = xb_ld(&bar[XB_XCNT(j)]); sum += c; cnt += (c > 0u) ? 1u : 0u; mine = (j == x) ? c : mine; }
        if (sum == G) break;
        __builtin_amdgcn_s_sleep(1);
        if ((++sp & 255u) == 0u) { if (xb_ld(&bar[XB_TMO])) break; if (sp > XB_SPIN_CAP) { atomicAdd(&bar[XB_TMO], 1u); break; } }
    }
    nloc = mine > 0u ? mine : 1u; nx = cnt > 0u ? cnt : 1u;
}

__device__ __forceinline__ void xcd_barrier(const XcdBarrier& b) {
    asm volatile("s_waitcnt vmcnt(0)" ::: "memory");
    __syncthreads();
    if (threadIdx.x == 0) {
        unsigned* bar = b.bar; asm volatile("" : "+s"(bar));
        __builtin_amdgcn_s_waitcnt(0);
        unsigned nloc = b.st[0], nx = b.st[1];
        if (nloc == 0u) { xcd_barrier_complete(bar, b.x, nloc, nx); b.st[0] = nloc; b.st[1] = nx; }
        const unsigned old = xb_add(&bar[XB_XSUB(b.x)], 1u);
        const unsigned gen = old / nloc;
        if (old + 1u == (gen + 1u) * nloc) {
            __builtin_amdgcn_fence(__ATOMIC_RELEASE, "agent");
            asm volatile("s_waitcnt vmcnt(0)" ::: "memory");
            const unsigned og = xb_add(&bar[XB_TOP], 1u);
            const unsigned tg = og / nx;
            if (og + 1u == (tg + 1u) * nx) xb_add(&bar[XB_TOPGEN], 1u);
            else XB_SPIN(xb_ld(&bar[XB_TOPGEN]) == tg, bar);
            __builtin_amdgcn_fence(__ATOMIC_ACQUIRE, "agent");
            xb_add(&bar[XB_XGEN(b.x)], 1u);
            asm volatile("s_waitcnt vmcnt(0)" ::: "memory");
        } else {
            XB_SPIN(xb_ld(&bar[XB_XGEN(b.x)]) == gen, bar);
            __builtin_amdgcn_fence(__ATOMIC_ACQUIRE, "agent");
            asm volatile("s_waitcnt vmcnt(0)" ::: "memory");
        }
    }
    __syncthreads();
}

#define DI __device__ __forceinline__
constexpr int NWAVES = 8;
constexpr int BATCH = 32, SEQ = 2048, DM = 1024, MTOK = BATCH * SEQ, DEPTH = 2;
constexpr int NIN = 4008, DFF = 2048, NMOD = 6 * DM;
constexpr float RMS_EPS = 1e-6f;
constexpr size_t MiB = 1u << 20;
constexpr size_t WS_CTL = 0, CTL_ZERO_BYTES = 1 * MiB;
constexpr size_t WS_MOD = 1 * MiB;
constexpr size_t WS_LAMJ = 3 * MiB;
constexpr size_t WS_BBAR = 5 * MiB;
constexpr size_t WS_KT = 6 * MiB;
constexpr size_t WS_W = 8 * MiB, W_SLOT = 28 * MiB;
constexpr size_t W_IN = 0, W_UP = 8 * MiB, W_DOWN = 16 * MiB, W_COMB = 20 * MiB, W_OUT = 22 * MiB, W_Q = 24 * MiB, W_PB = 25 * MiB, W_PC = 25 * MiB + 512 * 1024, W_GLU = 26 * MiB, W_POOL = 26 * MiB + 128 * 1024;
constexpr size_t WS_WY = 64 * MiB;
constexpr size_t WS_WE = 100 * MiB;
constexpr size_t WS_ZG = 108 * MiB;
constexpr size_t WS_ZS = 492 * MiB;
constexpr size_t WS_O = WS_ZS;
constexpr size_t WS_QQ = 620 * MiB;
constexpr size_t WS_MG = WS_QQ;
constexpr size_t WS_H = 780 * MiB;
constexpr size_t WS_CQN = 780 * MiB, WS_CKVN = 812 * MiB, WS_AS5 = 828 * MiB, WS_POOLED = 864 * MiB, WS_E = 896 * MiB, WS_KI = 904 * MiB;
constexpr size_t WS_SELQ = 908 * MiB, WS_ZSS = 924 * MiB, WS_YS = 956 * MiB, WS_YP = 988 * MiB, WS_WI = 1020 * MiB, WS_END = 1022 * MiB;
constexpr size_t WS_Y = 108 * MiB;
constexpr size_t WS_U = 108 * MiB;
constexpr size_t WS_A2 = 620 * MiB;
constexpr int AS5_LD = 1152;
constexpr int CW_BAR = 4096;
constexpr int RING_OFF = 0, RING_BYTES = 131072, LDSCTL_OFF = RING_BYTES, MISC_OFF = LDSCTL_OFF + 320, LDS_BYTES = 147456;

enum { I_X = 0, I_C, I_MODW, I_MODB, I_MIXPRE, I_MIXPOST, I_FFNPRE, I_FFNPOST, I_WIN, I_GCQ, I_WUQ, I_WQI, I_GCKV, I_WUV, I_ARE, I_AIM, I_BRE, I_BIM, I_CRE, I_CIM,
       I_DSKIP, I_LOGSTEP, I_WGLU, I_BGLU, I_WPOOL, I_PSCALE, I_PA, I_PB, I_PC, I_WOUT, I_WUP, I_CONVW, I_CONVB, I_WDOWN, N_INPUTS };
struct Args { const float* in[N_INPUTS]; float* out; unsigned char* ws; int ph_lo, ph_hi, li, pad; };

typedef float f32x2v __attribute__((ext_vector_type(2)));
typedef unsigned u32x2v __attribute__((ext_vector_type(2)));
struct Frame {
    LAS unsigned char* lds;
    volatile LAS unsigned* MISC;
    gu32* ctl;
    int wave, vcu, G;
    unsigned char* ws;
    float* out;
};
DI unsigned char* wsl(unsigned char* p) { asm volatile("" : "+s"(p)); return p; }
DI int lane_id() { int l; asm volatile("v_mbcnt_lo_u32_b32 %0, -1, 0\n\tv_mbcnt_hi_u32_b32 %0, -1, %0" : "=v"(l)); return l; }
DI float wave_sum(float v) {
#pragma unroll
    for (int o = 1; o < 64; o <<= 1) v += __shfl_xor(v, o);
    return v;
}
DI unsigned cvtpk(float lo, float hi) { unsigned r; asm volatile("v_cvt_pk_bf16_f32 %0, %1, %2" : "=v"(r) : "v"(lo), "v"(hi)); return r; }
DI float bflo(unsigned w) { return __uint_as_float(w << 16); }
DI float bfhi(unsigned w) { return __uint_as_float(w & 0xffff0000u); }
DI float sigm(float x) { return __builtin_amdgcn_rcpf(1.0f + __builtin_amdgcn_exp2f(-1.4426950408889634f * x)); }
DI float gelu_t(float x) { const float u = x * (1.5957691216057308f + 0.07135481627f * x * x); return x * sigm(u); }
DI bf16* wslot(const Frame& F, int l, size_t off) { return (bf16*)(wsl(F.ws) + WS_W + (size_t)l * W_SLOT + off); }

template <int MAP> DI int srcmap(int nd) { if (MAP == 0) return nd; return nd < 3072 ? 936 + nd : (nd - 3072 < 936 ? nd - 3072 : -1); }
template <int MAP> DI void p0_transpose_item(const float* W, int K, int Nsrc, int Ndst, bf16* WT, int ldk, int dst_row_off, LAS float* scr, int item, int lane) {
    const int nblk = Ndst / 32, kb = item / nblk, nb = item % nblk, k0 = 64 * kb, n0 = 32 * nb;
    const int ns = srcmap<MAP>(n0 + (lane & 31));
#pragma unroll 8
    for (int i = 0; i < 32; ++i) { const int kk = 2 * i + (lane >> 5); scr[kk * 33 + (lane & 31)] = (ns >= 0) ? W[(size_t)(k0 + kk) * Nsrc + ns] : 0.f; }
    LDS_WAIT(); asm volatile("" ::: "memory");
    const int c = lane & 7;
#pragma unroll
    for (int j = 0; j < 4; ++j) { const int n = (lane >> 3) + 8 * j; const LAS float* s = scr + (8 * c) * 33 + n;
        v4u o; o.x = cvtpk(s[0 * 33], s[1 * 33]); o.y = cvtpk(s[2 * 33], s[3 * 33]); o.z = cvtpk(s[4 * 33], s[5 * 33]); o.w = cvtpk(s[6 * 33], s[7 * 33]);
        *(GAS v4u*)(WT + (size_t)(dst_row_off + n0 + n) * ldk + k0 + 8 * c) = o; }
    LDS_WAIT(); asm volatile("" ::: "memory");
}
DI void p0_prologue(Frame& F, const Args& A) {
    LAS float* scr = (LAS float*)(F.lds + RING_OFF + F.wave * 16384);
    const int gw = F.vcu * NWAVES + F.wave, NGW = F.G * NWAVES, lane = lane_id();
    constexpr int I_IN = (DM / 64) * (4096 / 32), I_UQ = (256 / 64) * (1024 / 32), I_QI = (256 / 64) * (256 / 32), I_PBC = (256 / 64) * (1024 / 32), I_OUT = (DM / 64) * (DM / 32),
                  I_UPI = (DM / 64) * (4096 / 32), I_DN = (DFF / 64) * (DM / 32), I_GLU = (256 / 64) * (256 / 32);
    constexpr int PER_L = I_IN + I_UQ + I_QI + 2 * I_PBC + I_OUT + I_UPI + I_DN + I_GLU;
    for (int it = gw; it < DEPTH * PER_L; it += NGW) {
        const int l = it / PER_L; int r = it % PER_L;
        if (r < I_IN) { p0_transpose_item<1>(A.in[I_WIN] + (size_t)l * DM * NIN, DM, NIN, 4096, wslot(F, l, W_IN), DM, 0, scr, r, lane); continue; } r -= I_IN;
        if (r < I_UQ) { p0_transpose_item<0>(A.in[I_WUQ] + (size_t)l * 256 * 1024, 256, 1024, 1024, wslot(F, l, W_Q), 256, 0, scr, r, lane); continue; } r -= I_UQ;
        if (r < I_QI) { p0_transpose_item<0>(A.in[I_WQI] + (size_t)l * 256 * 256, 256, 256, 256, wslot(F, l, W_Q), 256, 1024, scr, r, lane); continue; } r -= I_QI;
        if (r < I_PBC) { p0_transpose_item<0>(A.in[I_PB] + (size_t)l * 256 * 1024, 256, 1024, 1024, wslot(F, l, W_PB), 256, 0, scr, r, lane); continue; } r -= I_PBC;
        if (r < I_PBC) { p0_transpose_item<0>(A.in[I_PC] + (size_t)l * 256 * 1024, 256, 1024, 1024, wslot(F, l, W_PC), 256, 0, scr, r, lane); continue; } r -= I_PBC;
        if (r < I_OUT) { p0_transpose_item<0>(A.in[I_WOUT] + (size_t)l * DM * DM, DM, DM, DM, wslot(F, l, W_OUT), DM, 0, scr, r, lane); continue; } r -= I_OUT;
        if (r < I_UPI) { p0_transpose_item<0>(A.in[I_WUP] + (size_t)l * DM * 4096, DM, 4096, 4096, wslot(F, l, W_UP), DM, 0, scr, r, lane); continue; } r -= I_UPI;
        if (r < I_DN) { p0_transpose_item<0>(A.in[I_WDOWN] + (size_t)l * DFF * DM, DFF, DM, DM, wslot(F, l, W_DOWN), DFF, 0, scr, r, lane); continue; } r -= I_DN;
        p0_transpose_item<0>(A.in[I_WGLU] + (size_t)l * 256 * 256, 256, 256, 256, wslot(F, l, W_GLU), 256, 0, scr, r, lane);
    }
    for (int it = gw; it < DEPTH * 8 * 16 * 4; it += NGW) {
        const int db = it & 3, nb = (it >> 2) & 15, h = (it >> 6) & 7, l = it >> 9, n = nb * 64 + lane;
        const float* pa = A.in[I_PA] + (size_t)l * 512 * 1024 + (size_t)(h * 64) * 1024 + n;
        const float* wuv = A.in[I_WUV] + (size_t)l * 8 * 128 * 64 + (size_t)(h * 128 + db * 32) * 64;
        for (int dg = 0; dg < 4; ++dg) {
            float a[8];
#pragma unroll
            for (int dd = 0; dd < 8; ++dd) a[dd] = 0.f;
#pragma unroll 2
            for (int e = 0; e < 64; ++e) { const float pe = pa[(size_t)e * 1024];
#pragma unroll
                for (int dd = 0; dd < 8; ++dd) a[dd] += wuv[(size_t)(dg * 8 + dd) * 64 + e] * pe; }
            v4u o; o.x = cvtpk(a[0], a[1]); o.y = cvtpk(a[2], a[3]); o.z = cvtpk(a[4], a[5]); o.w = cvtpk(a[6], a[7]);
            *(GAS v4u*)(wslot(F, l, W_COMB) + (size_t)n * 1024 + h * 128 + db * 32 + dg * 8) = o;
        }
    }
    for (int it = gw * 64 + lane; it < DEPTH * 256 * 256; it += NGW * 64) {
        const int l = it >> 16, n = (it >> 8) & 255, k = it & 255, g = n >> 6, d = n & 63, g2 = k >> 6, c = k & 63;
        const float v = (g == g2) ? A.in[I_WPOOL][(size_t)l * 4 * 64 * 64 + (size_t)(g * 64 + c) * 64 + d] * A.in[I_PSCALE][l * 256 + n] : 0.f;
        wslot(F, l, W_POOL)[(size_t)n * 256 + k] = (bf16)(cvtpk(v, 0.f) & 0xffffu);
    }
    {
        f32x2v* LAMJ = (f32x2v*)(wsl(F.ws) + WS_LAMJ); f32x2v* BBAR = (f32x2v*)(wsl(F.ws) + WS_BBAR);
        for (int it = gw * 64 + lane; it < DEPTH * 16 * 65 * 64; it += NGW * 64) {
            const int n = it & 63, j = (it >> 6) % 65, lg = (it >> 6) / 65;
            const float step = expf(A.in[I_LOGSTEP][lg]), ar = A.in[I_ARE][lg * 64 + n], ai = A.in[I_AIM][lg * 64 + n];
            const float mag = expf(ar * step * (float)j), ang = ai * step * (float)j;
            float sn, cs; sincosf(ang, &sn, &cs);
            LAMJ[it] = (f32x2v){mag * cs, mag * sn};
        }
        for (int it = gw * 64 + lane; it < DEPTH * 16 * 64 * 16; it += NGW * 64) {
            const int q = it & 15, n = (it >> 4) & 63, lg = it >> 10;
            const float step = expf(A.in[I_LOGSTEP][lg]), ar = A.in[I_ARE][lg * 64 + n], ai = A.in[I_AIM][lg * 64 + n];
            const float mag = expf(ar * step); float sn, cs; sincosf(ai * step, &sn, &cs);
            const float nr = mag * cs - 1.f, ni = mag * sn, den = 1.f / (ar * ar + ai * ai);
            const float fr_ = (nr * ar + ni * ai) * den, fi_ = (ni * ar - nr * ai) * den;
            const float br = A.in[I_BRE][(size_t)lg * 1024 + n * 16 + q], bi = A.in[I_BIM][(size_t)lg * 1024 + n * 16 + q];
            BBAR[it] = (f32x2v){fr_ * br - fi_ * bi, fr_ * bi + fi_ * br};
        }
    }
    {
        __syncthreads();
        LAS float* sil = (LAS float*)(F.lds + RING_OFF);
        float* MOD = (float*)(wsl(F.ws) + WS_MOD);
        for (int it = F.vcu; it < DEPTH * (NMOD / 64); it += F.G) {
            const int l = it / (NMOD / 64), n = (it % (NMOD / 64)) * 64 + lane, kw0 = F.wave * 128;
            LAS float* ms = sil + F.wave * 4096;
            for (int e = lane; e < 4096; e += 64) { const int kk = e >> 5, b = e & 31; const float cv = A.in[I_C][b * DM + kw0 + kk]; ms[e] = cv * sigm(cv); }
            LDS_WAIT(); asm volatile("" ::: "memory");
            float acc[32];
#pragma unroll
            for (int b = 0; b < 32; ++b) acc[b] = 0.f;
            const float* wp = A.in[I_MODW] + (size_t)l * DM * NMOD + (size_t)kw0 * NMOD + n;
            for (int kk = 0; kk < 128; ++kk) { const float w = wp[(size_t)kk * NMOD];
#pragma unroll
                for (int b = 0; b < 32; ++b) acc[b] += w * ms[kk * 32 + b]; }
            __syncthreads();
            LAS float* red = (LAS float*)(F.lds + RING_OFF);
#pragma unroll
            for (int b = 0; b < 32; ++b) red[(F.wave * 32 + b) * 64 + lane] = acc[b];
            __syncthreads();
            for (int e = F.wave * 64 + lane; e < 32 * 64; e += NWAVES * 64) { const int b = e >> 6, c = e & 63; float s = 0.f;
#pragma unroll
                for (int w = 0; w < 8; ++w) s += red[(w * 32 + b) * 64 + c];
                const int nn = (it % (NMOD / 64)) * 64 + c; MOD[((size_t)l * 32 + b) * NMOD + nn] = s + A.in[I_MODB][l * NMOD + nn]; }
            __syncthreads();
        }
    }
}
DI void p1_kt(Frame& F, const Args& A) {
    const f32x2v* LAMJ = (const f32x2v*)(wsl(F.ws) + WS_LAMJ); const f32x2v* BBAR = (const f32x2v*)(wsl(F.ws) + WS_BBAR); float* KT = (float*)(wsl(F.ws) + WS_KT);
    const int gt = (F.vcu * NWAVES + F.wave) * 64 + lane_id(), NGT = F.G * NWAVES * 64;
    for (int it = gt; it < DEPTH * 16 * 64 * 256; it += NGT) {
        const int q = it & 15, p = (it >> 4) & 15, j = (it >> 8) & 63, lg = it >> 14;
        const float* cre = A.in[I_CRE] + (size_t)lg * 1024 + p * 64; const float* cim = A.in[I_CIM] + (size_t)lg * 1024 + p * 64;
        float a = 0.f;
        for (int n = 0; n < 64; ++n) { const f32x2v lj = LAMJ[((size_t)lg * 65 + j) * 64 + n], bb = BBAR[((size_t)lg * 64 + n) * 16 + q];
            const float tr = lj.x * bb.x - lj.y * bb.y, ti = lj.x * bb.y + lj.y * bb.x;
            a += cre[n] * tr - cim[n] * ti; }
        if (j == 0 && p == q) a += A.in[I_DSKIP][lg * 16 + p];
        KT[it] = a;
    }
}
DI void s5_expand(Frame& F, const Args& A, int l) {
    const f32x2v* LAMJ = (const f32x2v*)(wsl(F.ws) + WS_LAMJ) + (size_t)l * 16 * 65 * 64; const f32x2v* BBAR = (const f32x2v*)(wsl(F.ws) + WS_BBAR) + (size_t)l * 16 * 64 * 16;
    const float* KT = (const float*)(wsl(F.ws) + WS_KT) + (size_t)l * 16 * 64 * 256;
    bf16* WY = (bf16*)(wsl(F.ws) + WS_WY); bf16* WE = (bf16*)(wsl(F.ws) + WS_WE);
    const int gt = (F.vcu * NWAVES + F.wave) * 64 + lane_id(), NGT = F.G * NWAVES * 64;
    for (int it = gt; it < 16 * 1024 * (AS5_LD / 8); it += NGT) {
        const int k8 = it % (AS5_LD / 8), row = it / (AS5_LD / 8), g = row >> 10, t = (row >> 4) & 63, p = row & 15, k = k8 * 8;
        float v[8];
        if (k < 1024) { const int s = k >> 4, q0 = k & 15;
            if (s <= t) { const float* kp = KT + ((size_t)(g * 64 + (t - s)) * 16 + p) * 16 + q0;
#pragma unroll
                for (int e = 0; e < 8; ++e) v[e] = kp[e]; }
            else {
#pragma unroll
                for (int e = 0; e < 8; ++e) v[e] = 0.f; }
        } else { const bool im = k >= 1088; const int n0 = (k - 1024) & 63;
            const float* cre = A.in[I_CRE] + (size_t)(l * 16 + g) * 1024 + p * 64 + n0; const float* cim = A.in[I_CIM] + (size_t)(l * 16 + g) * 1024 + p * 64 + n0;
#pragma unroll
            for (int e = 0; e < 8; ++e) { const f32x2v lj = LAMJ[((size_t)g * 65 + (t + 1)) * 64 + n0 + e];
                v[e] = im ? -(cre[e] * lj.y + cim[e] * lj.x) : (cre[e] * lj.x - cim[e] * lj.y); } }
        v4u o; o.x = cvtpk(v[0], v[1]); o.y = cvtpk(v[2], v[3]); o.z = cvtpk(v[4], v[5]); o.w = cvtpk(v[6], v[7]);
        *(GAS v4u*)(WY + (size_t)row * AS5_LD + k) = o;
    }
    for (int it = gt; it < 16 * 256 * 128; it += NGT) {
        const int k8 = it & 127, row = it >> 7, g = row >> 8, r = row & 255, k = k8 * 8, s = k >> 4, q0 = k & 15;
        float v[8];
        if (r < 128) { const int n = r & 63; const f32x2v lj = LAMJ[((size_t)g * 65 + (63 - s)) * 64 + n];
#pragma unroll
            for (int e = 0; e < 8; ++e) { const f32x2v bb = BBAR[((size_t)g * 64 + n) * 16 + q0 + e]; v[e] = (r < 64) ? (lj.x * bb.x - lj.y * bb.y) : (lj.x * bb.y + lj.y * bb.x); } }
        else {
#pragma unroll
            for (int e = 0; e < 8; ++e) v[e] = 0.f; }
        v4u o; o.x = cvtpk(v[0], v[1]); o.y = cvtpk(v[2], v[3]); o.z = cvtpk(v[4], v[5]); o.w = cvtpk(v[6], v[7]);
        *(GAS v4u*)(WE + (size_t)row * 1024 + k) = o;
    }
}

DI void norm_rows(Frame& F, const float* xin, const bf16* Y, const float* gt, const float* gpost, float* xout,
                  const float* gpre, const float* sc, const float* sh, bf16* Hout) {
    const int gw = F.vcu * NWAVES + F.wave, NGW = F.G * NWAVES, lane = lane_id();
    for (int m = gw; m < MTOK; m += NGW) {
        const int b = m / SEQ;
        f32x4 x[4];
        { const GAS f32x4* xr = (const GAS f32x4*)(xin + (size_t)m * DM) + lane;
#pragma unroll
          for (int j = 0; j < 4; ++j) x[j] = xr[64 * j]; }
        if (Y) {
            f32x4 y[4]; float s = 0.f;
            const GAS u32x2v* yr = (const GAS u32x2v*)(Y + (size_t)m * DM) + lane;
#pragma unroll
            for (int j = 0; j < 4; ++j) { const u32x2v w = yr[64 * j]; y[j] = (f32x4){bflo(w.x), bfhi(w.x), bflo(w.y), bfhi(w.y)}; s += (y[j].x * y[j].x + y[j].y * y[j].y) + (y[j].z * y[j].z + y[j].w * y[j].w); }
            const float r = 1.0f / sqrtf(wave_sum(s) * (1.f / DM) + RMS_EPS);
            GAS f32x4* xo = (GAS f32x4*)(xout + (size_t)m * DM) + lane;
#pragma unroll
            for (int j = 0; j < 4; ++j) { const f32x4 g = *((const GAS f32x4*)gpost + lane + 64 * j), t = *((const GAS f32x4*)(gt + (size_t)b * NMOD) + lane + 64 * j);
                x[j] = x[j] + t * (y[j] * r * g); xo[64 * j] = x[j]; }
        }
        if (Hout) {
            float s = 0.f;
#pragma unroll
            for (int j = 0; j < 4; ++j) s += (x[j].x * x[j].x + x[j].y * x[j].y) + (x[j].z * x[j].z + x[j].w * x[j].w);
            const float r = 1.0f / sqrtf(wave_sum(s) * (1.f / DM) + RMS_EPS);
            GAS u32x2v* ho = (GAS u32x2v*)(Hout + (size_t)m * DM) + lane;
#pragma unroll
            for (int j = 0; j < 4; ++j) { const f32x4 g = *((const GAS f32x4*)gpre + lane + 64 * j), a = *((const GAS f32x4*)(sc + (size_t)b * NMOD) + lane + 64 * j), c = *((const GAS f32x4*)(sh + (size_t)b * NMOD) + lane + 64 * j);
                const f32x4 h = x[j] * r * g * (a + 1.0f) + c; u32x2v w; w.x = cvtpk(h.x, h.y); w.y = cvtpk(h.z, h.w); ho[64 * j] = w; }
        }
    }
}
DI void small_ops(Frame& F, const Args& A, int l) {
    const int gw = F.vcu * NWAVES + F.wave, NGW = F.G * NWAVES, lane = lane_id();
    const bf16* ZS = (const bf16*)(wsl(F.ws) + WS_ZS);
    bf16* CQN = (bf16*)(wsl(F.ws) + WS_CQN); bf16* CKVN = (bf16*)(wsl(F.ws) + WS_CKVN); bf16* KI = (bf16*)(wsl(F.ws) + WS_KI); float* WI = (float*)(wsl(F.ws) + WS_WI);
    bf16* AS5 = (bf16*)(wsl(F.ws) + WS_AS5); bf16* PO = (bf16*)(wsl(F.ws) + WS_POOLED);
    const float* gcq = A.in[I_GCQ] + l * 256; const float* gckv = A.in[I_GCKV] + l * 128;
    for (int m = gw; m < MTOK; m += NGW) {
        const bf16* zr = ZS + (size_t)m * 1024;
        const v4u w0 = *(const GAS v4u*)(zr + 8 * lane), w1 = *(const GAS v4u*)(zr + 512 + 8 * lane);
        float a[8] = {bflo(w0.x), bfhi(w0.x), bflo(w0.y), bfhi(w0.y), bflo(w0.z), bfhi(w0.z), bflo(w0.w), bfhi(w0.w)};
        float ss = 0.f;
#pragma unroll
        for (int e = 0; e < 8; ++e) ss += a[e] * a[e];
        const float s_cq = wave_sum(lane < 32 ? ss : 0.f), s_kv = wave_sum((lane >= 32 && lane < 48) ? ss : 0.f);
        const float r_cq = 1.0f / sqrtf(s_cq * (1.f / 256.f) + RMS_EPS), r_kv = 1.0f / sqrtf(s_kv * (1.f / 128.f) + RMS_EPS);
        if (lane < 32) { const f32x4 g0 = *(const GAS f32x4*)(gcq + 8 * lane), g1 = *(const GAS f32x4*)(gcq + 8 * lane + 4);
            v4u o; o.x = cvtpk(a[0] * r_cq * g0.x, a[1] * r_cq * g0.y); o.y = cvtpk(a[2] * r_cq * g0.z, a[3] * r_cq * g0.w); o.z = cvtpk(a[4] * r_cq * g1.x, a[5] * r_cq * g1.y); o.w = cvtpk(a[6] * r_cq * g1.z, a[7] * r_cq * g1.w);
            *(GAS v4u*)(CQN + (size_t)m * 256 + 8 * lane) = o; }
        else if (lane < 48) { const int c = 8 * (lane - 32); const f32x4 g0 = *(const GAS f32x4*)(gckv + c), g1 = *(const GAS f32x4*)(gckv + c + 4);
            v4u o; o.x = cvtpk(a[0] * r_kv * g0.x, a[1] * r_kv * g0.y); o.y = cvtpk(a[2] * r_kv * g0.z, a[3] * r_kv * g0.w); o.z = cvtpk(a[4] * r_kv * g1.x, a[5] * r_kv * g1.y); o.w = cvtpk(a[6] * r_kv * g1.z, a[7] * r_kv * g1.w);
            *(GAS v4u*)(CKVN + (size_t)m * 128 + c) = o; }
        else if (lane < 52) { *(GAS v4u*)(KI + (size_t)m * 32 + 8 * (lane - 48)) = w0; }
        else if (lane == 52) { *(GAS f32x4*)(WI + (size_t)m * 8) = (f32x4){a[0], a[1], a[2], a[3]}; *(GAS f32x4*)(WI + (size_t)m * 8 + 4) = (f32x4){a[4], a[5], a[6], a[7]}; }
        const int b = m / SEQ, t = m % SEQ, kc = t >> 6, s = t & 63;
        if (lane >= 53) { const int p = lane - 53, g = p >> 1, q0 = 8 * (p & 1);
            *(GAS v4u*)(AS5 + (size_t)(g * 1024 + b * 32 + kc) * AS5_LD + s * 16 + q0) = w0; }
        if (lane <= 20) { const int p = lane + 11, g = p >> 1, q0 = 8 * (p & 1);
            *(GAS v4u*)(AS5 + (size_t)(g * 1024 + b * 32 + kc) * AS5_LD + s * 16 + q0) = w1; }
        if (lane >= 21 && lane <= 52) {
            const int pp = lane - 21, win = 2 << (pp >> 3), cnt = (t + 1 < win) ? (t + 1) : win;
            const float u[8] = {bflo(w1.x), bfhi(w1.x), bflo(w1.y), bfhi(w1.y), bflo(w1.z), bfhi(w1.z), bflo(w1.w), bfhi(w1.w)};
            float sm[8];
#pragma unroll
            for (int e = 0; e < 8; ++e) sm[e] = u[e];
            for (int i = 1; i < cnt; ++i) { const v4u wv = *(const GAS v4u*)(zr - (size_t)i * 1024 + 512 + 8 * lane);
                sm[0] += bflo(wv.x); sm[1] += bfhi(wv.x); sm[2] += bflo(wv.y); sm[3] += bfhi(wv.y); sm[4] += bflo(wv.z); sm[5] += bfhi(wv.z); sm[6] += bflo(wv.w); sm[7] += bfhi(wv.w); }
            const float ic = 1.0f / (float)cnt;
            v4u o; o.x = cvtpk(sm[0] * ic - u[0], sm[1] * ic - u[1]); o.y = cvtpk(sm[2] * ic - u[2], sm[3] * ic - u[3]); o.z = cvtpk(sm[4] * ic - u[4], sm[5] * ic - u[5]); o.w = cvtpk(sm[6] * ic - u[6], sm[7] * ic - u[7]);
            *(GAS v4u*)(PO + (size_t)m * 256 + 8 * pp) = o;
        }
    }
}
DI void s5_scan(Frame& F, int l) {
    const int gw = F.vcu * NWAVES + F.wave, NGW = F.G * NWAVES, n = lane_id();
    const f32x2v* LAMJ = (const f32x2v*)(wsl(F.ws) + WS_LAMJ) + (size_t)l * 16 * 65 * 64; const float* E = (const float*)(wsl(F.ws) + WS_E); bf16* AS5 = (bf16*)(wsl(F.ws) + WS_AS5);
    for (int it = gw; it < 16 * BATCH; it += NGW) {
        const int g = it >> 5, b = it & 31; const f32x2v lam = LAMJ[((size_t)g * 65 + 64) * 64 + n];
        float sr = 0.f, si = 0.f; const size_t row0 = (size_t)g * 1024 + b * 32;
#pragma unroll 4
        for (int k = 0; k < 32; ++k) {
            bf16* ar = AS5 + (row0 + k) * AS5_LD + 1024;
            ar[n] = (bf16)(cvtpk(sr, 0.f) & 0xffffu); ar[64 + n] = (bf16)(cvtpk(si, 0.f) & 0xffffu);
            const float er = E[(row0 + k) * 128 + n], ei = E[(row0 + k) * 128 + 64 + n];
            const float nr = lam.x * sr - lam.y * si + er, ni = lam.x * si + lam.y * sr + ei; sr = nr; si = ni;
        }
    }
}
DI void conv_gate(Frame& F, const Args& A, int l) {
    const int gw = F.vcu * NWAVES + F.wave, NGW = F.G * NWAVES, lane = lane_id();
    const bf16* U = (const bf16*)(wsl(F.ws) + WS_U); bf16* A2 = (bf16*)(wsl(F.ws) + WS_A2);
    const float* cw = A.in[I_CONVW] + (size_t)l * 3 * 4096; const float* cb = A.in[I_CONVB] + (size_t)l * 4096;
    for (int it = gw; it < (MTOK / 64) * 4; it += NGW) {
        const int cbk = it & 3, run = it >> 2, j0 = cbk * 512 + lane * 8, t0 = run * 64;
        float wg[3][8], wv[3][8], bg[8], bv[8];
#pragma unroll
        for (int k = 0; k < 3; ++k)
#pragma unroll
            for (int e = 0; e < 8; ++e) { wg[k][e] = cw[k * 4096 + j0 + e]; wv[k][e] = cw[k * 4096 + 2048 + j0 + e]; }
#pragma unroll
        for (int e = 0; e < 8; ++e) { bg[e] = cb[j0 + e]; bv[e] = cb[2048 + j0 + e]; }
        v4u g1 = {0, 0, 0, 0}, g2 = {0, 0, 0, 0}, v1 = {0, 0, 0, 0}, v2 = {0, 0, 0, 0};
        if ((t0 % SEQ) != 0) { const bf16* p1 = U + (size_t)(t0 - 1) * 4096 + j0; const bf16* p2 = U + (size_t)(t0 - 2) * 4096 + j0;
            g1 = *(const GAS v4u*)p1; v1 = *(const GAS v4u*)(p1 + 2048); g2 = *(const GAS v4u*)p2; v2 = *(const GAS v4u*)(p2 + 2048); }
        for (int r = 0; r < 64; ++r) {
            const bf16* p0 = U + (size_t)(t0 + r) * 4096 + j0;
            const v4u g0 = *(const GAS v4u*)p0, v0 = *(const GAS v4u*)(p0 + 2048);
            const unsigned G0[4] = {g0.x, g0.y, g0.z, g0.w}, G1[4] = {g1.x, g1.y, g1.z, g1.w}, G2[4] = {g2.x, g2.y, g2.z, g2.w};
            const unsigned V0[4] = {v0.x, v0.y, v0.z, v0.w}, V1[4] = {v1.x, v1.y, v1.z, v1.w}, V2[4] = {v2.x, v2.y, v2.z, v2.w};
            unsigned o[4];
#pragma unroll
            for (int h = 0; h < 4; ++h) {
                const float ga = bg[2 * h] + wg[0][2 * h] * bflo(G2[h]) + wg[1][2 * h] * bflo(G1[h]) + wg[2][2 * h] * bflo(G0[h]);
                const float gb = bg[2 * h + 1] + wg[0][2 * h + 1] * bfhi(G2[h]) + wg[1][2 * h + 1] * bfhi(G1[h]) + wg[2][2 * h + 1] * bfhi(G0[h]);
                const float va = bv[2 * h] + wv[0][2 * h] * bflo(V2[h]) + wv[1][2 * h] * bflo(V1[h]) + wv[2][2 * h] * bflo(V0[h]);
                const float vb = bv[2 * h + 1] + wv[0][2 * h + 1] * bfhi(V2[h]) + wv[1][2 * h + 1] * bfhi(V1[h]) + wv[2][2 * h + 1] * bfhi(V0[h]);
                o[h] = cvtpk(gelu_t(ga) * va, gelu_t(gb) * vb);
            }
            *(GAS v4u*)(A2 + (size_t)(t0 + r) * 2048 + j0) = (v4u){o[0], o[1], o[2], o[3]};
            g2 = g1; v2 = v1; g1 = g0; v1 = v0;
        }
    }
}

using f32x16 = __attribute__((ext_vector_type(16))) float;
#define SBAR() __builtin_amdgcn_sched_barrier(0)
using s16x4 = __attribute__((ext_vector_type(4))) short;
DI void dsa_unit(int i2, int e, int& b, int& qb) { b = i2 >> 3; const int kk = i2 & 7; qb = (e >> 1) * 16 + ((e & 1) ? 15 - kk : kk); }
DI unsigned swap32(unsigned v) { auto rr = __builtin_amdgcn_permlane32_swap(v, v, false, false); return rr[0] ^ rr[1] ^ v; }

DI void indexer_unit(Frame& F, int b, int qb) {
    const int lane = lane_id(), wave = F.wave, r32 = lane & 31, hi = lane >> 5;
    const bf16* QQ = (const bf16*)(wsl(F.ws) + WS_QQ); const bf16* KI = (const bf16*)(wsl(F.ws) + WS_KI); const float* WI = (const float*)(wsl(F.ws) + WS_WI); unsigned* SELQ = (unsigned*)(wsl(F.ws) + WS_SELQ);
    LAS unsigned* cnts = (LAS unsigned*)(F.lds + RING_OFF);
    const int c = qb >> 1, nkeys = 64 * (c + 1), nsub = nkeys >> 5, NT = c + 1, nsub_eff = 2 * (NT + (NT & 1));
    const int sq = qb * 32 + r32; const size_t q = (size_t)b * SEQ + sq;
    LAS bf16x8* qis = (LAS bf16x8*)(F.lds + RING_OFF + 4096);
#pragma unroll
    for (int ks = 0; ks < 2; ++ks) qis[(wave * 2 + ks) * 64 + lane] = *(const GAS bf16x8*)(QQ + q * 1280 + 1024 + wave * 32 + ks * 16 + 8 * hi);
    float w[8];
#pragma unroll
    for (int h = 0; h < 8; ++h) w[h] = WI[q * 8 + h];
    __syncthreads();
    unsigned uk[8][16]; const int koff = r32 * 32 + 8 * hi;
#pragma unroll
    for (int ul = 0; ul < 8; ++ul) {
        const int u = ul * 8 + wave;
        if (u < nsub) {
            const bf16* kp = (KI + ((size_t)b * SEQ + 32 * u) * 32) + koff;
            const bf16x8 a0 = *(const GAS bf16x8*)kp, a1 = *(const GAS bf16x8*)(kp + 16);
            float sc[16];
#pragma unroll
            for (int r = 0; r < 16; ++r) sc[r] = 0.f;
#pragma unroll
            for (int h = 0; h < 8; ++h) {
                const bf16x8 q0 = qis[(h * 2 + 0) * 64 + lane], q1 = qis[(h * 2 + 1) * 64 + lane];
                f32x16 cc = {0.f, 0.f, 0.f, 0.f, 0.f, 0.f, 0.f, 0.f, 0.f, 0.f, 0.f, 0.f, 0.f, 0.f, 0.f, 0.f};
                cc = __builtin_amdgcn_mfma_f32_32x32x16_bf16(a0, q0, cc, 0, 0, 0);
                cc = __builtin_amdgcn_mfma_f32_32x32x16_bf16(a1, q1, cc, 0, 0, 0);
#pragma unroll
                for (int r = 0; r < 16; ++r) sc[r] += fmaxf(cc[r], 0.f) * w[h];
                asm volatile("" : "+v"(sc[0]), "+v"(sc[1]), "+v"(sc[2]), "+v"(sc[3]), "+v"(sc[4]), "+v"(sc[5]), "+v"(sc[6]), "+v"(sc[7]), "+v"(sc[8]), "+v"(sc[9]), "+v"(sc[10]), "+v"(sc[11]), "+v"(sc[12]), "+v"(sc[13]), "+v"(sc[14]), "+v"(sc[15]));
            }
#pragma unroll
            for (int r = 0; r < 16; ++r) { const unsigned bits = __float_as_uint(sc[r] + 0.0f); uk[ul][r] = bits ^ ((unsigned)((int)bits >> 31) | 0x80000000u); }
        } else {
#pragma unroll
            for (int r = 0; r < 16; ++r) uk[ul][r] = 0u;
        }
        SBAR(); asm volatile("" ::: "memory");
    }
    unsigned T = 0u, cntT = (unsigned)nkeys; int buf = 0;
    if (nkeys > 256) {
        for (int bit = 31; bit >= 0; --bit) {
            if (__all(cntT == 256u)) break;
            const unsigned cand = T | (1u << bit);
            unsigned cl = 0u;
#pragma unroll
            for (int ul = 0; ul < 8; ++ul)
#pragma unroll
                for (int r = 0; r < 16; ++r) cl += (uk[ul][r] >= cand) ? 1u : 0u;
            cl += swap32(cl);
            if (hi == 0) cnts[(buf * 8 + wave) * 32 + r32] = cl;
            __syncthreads();
            unsigned tot = 0u;
#pragma unroll
            for (int w8 = 0; w8 < 8; ++w8) tot += cnts[(buf * 8 + w8) * 32 + r32];
            if (cntT != 256u && tot >= 256u) { T = cand; cntT = tot; }
            buf ^= 1;
        }
    }
#pragma unroll
    for (int ul = 0; ul < 8; ++ul) {
        const int u = ul * 8 + wave;
        if (u < nsub_eff) {
            unsigned word = 0u;
            if (u < nsub) {
#pragma unroll
                for (int r = 0; r < 16; ++r) word |= (uk[ul][r] >= T) ? (1u << ((r & 3) + 8 * (r >> 2) + 4 * hi)) : 0u;
                word |= swap32(word);
            }
            if (hi == 0) (SELQ + ((size_t)(b * 32 + (u >> 1)) * 2 + (u & 1)) * SEQ)[sq] = word;
        }
    }
    __syncthreads();
}
DI void indexer_phase(Frame& F) {
#pragma nounroll
    for (int i2 = F.vcu; i2 < 256; i2 += F.G) {
#pragma nounroll
        for (int e = 0; e < 8; ++e) { int b, qb; dsa_unit(i2, e, b, qb); indexer_unit(F, b, qb); } }
}

constexpr int AD = 128, KVBLK = 64;
constexpr float ATT_SCALE = 0.088388347648318440f, ATT_THR = 8.f;
constexpr size_t SHM_V = KVBLK * AD * 2, SHM_K = KVBLK * AD * 2;
#define KSWZ(row, colB) ((row) * 256 + ((colB) ^ (((row) & 7) << 4)))
DI int crow(int r, int hi) { return (r & 3) + 8 * (r >> 2) + 4 * hi; }
DI void partialSM(f32x16& p0, f32x16& p1, float& m_reg, float& mn, float& alpha, unsigned w0, unsigned w1, float tl, float na, int hi) {
    constexpr float C = ATT_SCALE * 1.4426950408889634f;
    const unsigned s0 = w0 >> (4 * hi), s1 = w1 >> (4 * hi); const float tlh = tl - (float)(4 * hi);
#pragma unroll
    for (int r = 0; r < 16; ++r) { const int cpos = (r & 3) + 8 * (r >> 2);
        const float d0 = tlh - (float)cpos;
        p0[r] = (s0 & (1u << cpos)) ? fmaf(fabsf(d0), na, p0[r]) : -1e30f;
        if ((r & 3) == 3) SBAR(); }
#pragma unroll
    for (int r = 0; r < 16; ++r) { const int cpos = (r & 3) + 8 * (r >> 2);
        const float d1 = tlh - (float)(32 + cpos);
        p1[r] = (s1 & (1u << cpos)) ? fmaf(fabsf(d1), na, p1[r]) : -1e30f;
        if ((r & 3) == 3) SBAR(); }
    float pmax = p0[0];
#pragma unroll
    for (int r = 1; r < 16; ++r) pmax = fmaxf(pmax, p0[r]);
#pragma unroll
    for (int r = 0; r < 16; ++r) pmax = fmaxf(pmax, p1[r]);
    { auto rr = __builtin_amdgcn_permlane32_swap(__float_as_uint(pmax), __float_as_uint(pmax), false, false);
      pmax = fmaxf(__uint_as_float(rr[0]), __uint_as_float(rr[1])); }
    if (__builtin_expect(__all(pmax - m_reg <= ATT_THR / ATT_SCALE), 1)) { mn = m_reg; alpha = 1.f; }
    else { mn = fmaxf(m_reg, pmax); alpha = __builtin_amdgcn_exp2f((m_reg - mn) * C); m_reg = mn; }
    const float mnC = -mn * C;
#pragma unroll
    for (int r = 0; r < 16; ++r) p0[r] = fmaf(p0[r], C, mnC);
#pragma unroll
    for (int r = 0; r < 16; ++r) p1[r] = fmaf(p1[r], C, mnC);
#pragma unroll
    for (int r = 0; r < 16; ++r) p0[r] = __builtin_amdgcn_exp2f(p0[r]);
}
DI void finishSM(f32x16& p0, f32x16& p1, float alpha, float& l_reg, bf16x8& pa0, bf16x8& pa1, bf16x8& pa2, bf16x8& pa3) {
#pragma unroll
    for (int r = 0; r < 16; ++r) p1[r] = __builtin_amdgcn_exp2f(p1[r]);
    float ps = 0;
#pragma unroll
    for (int r = 0; r < 16; ++r) ps += p0[r];
#pragma unroll
    for (int r = 0; r < 16; ++r) ps += p1[r];
    { auto rr = __builtin_amdgcn_permlane32_swap(__float_as_uint(ps), __float_as_uint(ps), false, false);
      ps = __uint_as_float(rr[0]) + __uint_as_float(rr[1]); }
    l_reg = l_reg * alpha + ps;
#define PK4(P, BASE, OUT) do { unsigned a0 = cvtpk(P[BASE + 0], P[BASE + 1]), a1 = cvtpk(P[BASE + 2], P[BASE + 3]);   \
    unsigned b0 = cvtpk(P[BASE + 4], P[BASE + 5]), b1 = cvtpk(P[BASE + 6], P[BASE + 7]);                              \
    auto r0 = __builtin_amdgcn_permlane32_swap(a0, b0, false, false); auto r1 = __builtin_amdgcn_permlane32_swap(a1, b1, false, false); \
    v4u w = {r0[0], r1[0], r0[1], r1[1]}; OUT = *reinterpret_cast<bf16x8*>(&w); } while (0)
    PK4(p0, 0, pa0); PK4(p0, 8, pa1); PK4(p1, 0, pa2); PK4(p1, 8, pa3);
#undef PK4
}
DI void qkt(f32x16& p0, f32x16& p1, const char* Ks, const bf16x8* qr, int r32, int hi) {
    p0 = f32x16{}; p1 = f32x16{};
#pragma unroll
    for (int d0 = 0; d0 < 8; ++d0) { const int cb = (d0 * 16 + hi * 8) * 2;
        const bf16x8 b0 = *reinterpret_cast<const bf16x8*>(Ks + KSWZ(r32, cb));
        const bf16x8 b1 = *reinterpret_cast<const bf16x8*>(Ks + KSWZ(32 + r32, cb));
        p0 = __builtin_amdgcn_mfma_f32_32x32x16_bf16(b0, qr[d0], p0, 0, 0, 0);
        p1 = __builtin_amdgcn_mfma_f32_32x32x16_bf16(b1, qr[d0], p1, 0, 0, 0); }
}
DI int v_st(int k, int c) { const int kk = (k & ~0xC) | ((k & 4) << 1) | ((k & 8) >> 1); return ((kk >> 3) * 4 + (c >> 5)) * 512 + ((kk & 7) * 32 + (c & 31)) * 2; }
DI int v_rd_base(int lane) { return ((lane & 3) << 3) | (((lane >> 2) & 3) << 6) | (((lane >> 4) & 1) << 5) | (((lane >> 5) & 1) << 8); }
constexpr int v_rd_off(int d0, int ks, int half) { return d0 * 512 + ks * 4096 + half * 2048; }
template <int OFF> DI s16x4 tr_read(int vb) { s16x4 r; asm volatile("ds_read_b64_tr_b16 %0, %1 offset:%2" : "=&v"(r) : "v"(vb), "i"(OFF) : "memory"); return r; }
template <int D0> DI void pv_one(f32x16& od, int vb, bf16x8 pa0, bf16x8 pa1, bf16x8 pa2, bf16x8 pa3) {
    const s16x4 l0 = tr_read<v_rd_off(D0, 0, 0)>(vb), h0 = tr_read<v_rd_off(D0, 0, 1)>(vb), l1 = tr_read<v_rd_off(D0, 1, 0)>(vb), h1 = tr_read<v_rd_off(D0, 1, 1)>(vb);
    const s16x4 l2 = tr_read<v_rd_off(D0, 2, 0)>(vb), h2 = tr_read<v_rd_off(D0, 2, 1)>(vb), l3 = tr_read<v_rd_off(D0, 3, 0)>(vb), h3 = tr_read<v_rd_off(D0, 3, 1)>(vb);
    asm volatile("s_waitcnt lgkmcnt(0)" ::: "memory"); SBAR();
#define PKV(L, H) (bf16x8){L[0], L[1], L[2], L[3], H[0], H[1], H[2], H[3]}
    od = __builtin_amdgcn_mfma_f32_32x32x16_bf16(pa0, PKV(l0, h0), od, 0, 0, 0);
    od = __builtin_amdgcn_mfma_f32_32x32x16_bf16(pa1, PKV(l1, h1), od, 0, 0, 0);
    od = __builtin_amdgcn_mfma_f32_32x32x16_bf16(pa2, PKV(l2, h2), od, 0, 0, 0);
    od = __builtin_amdgcn_mfma_f32_32x32x16_bf16(pa3, PKV(l3, h3), od, 0, 0, 0);
#undef PKV
}
DI void pv_d0(f32x16* o, int vb, bf16x8 pa0, bf16x8 pa1, bf16x8 pa2, bf16x8 pa3) {
    pv_one<0>(o[0], vb, pa0, pa1, pa2, pa3); pv_one<1>(o[1], vb, pa0, pa1, pa2, pa3); pv_one<2>(o[2], vb, pa0, pa1, pa2, pa3); pv_one<3>(o[3], vb, pa0, pa1, pa2, pa3);
}
DI void attn_unit(Frame& F, int b, int qb, char* lds) {
    const int wid = F.wave, lane = lane_id(), tid = wid * 64 + lane, r32 = lane & 31, hi = lane >> 5;
    const bf16* QQ = (const bf16*)(wsl(F.ws) + WS_QQ); const bf16* Kh = (const bf16*)(wsl(F.ws) + WS_CKVN) + (size_t)b * SEQ * AD; const unsigned* SELQ = (const unsigned*)(wsl(F.ws) + WS_SELQ);
    bf16* O = (bf16*)(wsl(F.ws) + WS_O);
    char* V_lds = lds; char* K_lds = lds + 2 * SHM_V;
    float* wsf = (float*)(lds + 2 * SHM_V + 2 * SHM_K) + wid * 64; float* li_l = wsf; float* al_l = wsf + 32;
    float m_reg = -1e6f, l_reg = 0; f32x16 o[4] = {}; bf16x8 qr[8];
    const int sq = qb * 32 + r32;
    const bf16* Qw = QQ + ((size_t)b * SEQ + sq) * 1280 + wid * AD + hi * 8;
#pragma unroll
    for (int d0 = 0; d0 < 8; ++d0) qr[d0] = *(const GAS bf16x8*)(Qw + d0 * 16);
    int NT = (qb >> 1) + 1; NT += NT & 1;
    const float na = -exp2f(-(float)(wid + 1)) / ATT_SCALE, tq = (float)sq;
    const unsigned* selp = SELQ + (size_t)b * 32 * 2 * SEQ + sq;
    const int sr = tid >> 4, scc = (tid & 15) * 8, vst0 = v_st(sr, scc), vst1 = v_st(32 + sr, scc);
    const int vb0 = (int)(uintptr_t)V_lds + v_rd_base(lane);
    bf16x8 st0[2], st1[2];
#define SLOAD(i, k0) do { st0[i] = *(const GAS bf16x8*)(Kh + (size_t)((k0) + sr) * AD + scc); st1[i] = *(const GAS bf16x8*)(Kh + (size_t)((k0) + 32 + sr) * AD + scc); } while (0)
#define SWRITE(bb, i) do { *(bf16x8*)(V_lds + (bb) * SHM_V + vst0) = st0[i]; *(bf16x8*)(V_lds + (bb) * SHM_V + vst1) = st1[i]; const int kc = scc * 2; \
    *(bf16x8*)(K_lds + (bb) * SHM_K + KSWZ(sr, kc)) = st0[i]; *(bf16x8*)(K_lds + (bb) * SHM_K + KSWZ(32 + sr, kc)) = st1[i]; } while (0)
#define SWAIT() asm volatile("s_waitcnt vmcnt(2)" ::: "memory")
#define RESC(a) do { if (__any((a) < 1.f)) { if (hi == 0) al_l[r32] = (a); asm volatile("s_waitcnt lgkmcnt(0)" ::: "memory"); \
    _Pragma("unroll") for (int d = 0; d < 4; ++d) _Pragma("unroll") for (int r = 0; r < 16; ++r) o[d][r] *= al_l[crow(r, hi)]; } } while (0)
#define MASKW(j, wa, wb) do { wa = selp[(size_t)((j) * 2) * SEQ]; wb = selp[(size_t)((j) * 2 + 1) * SEQ]; } while (0)
    f32x16 pA0, pA1, pB0, pB1; float mnA, mnB, alA, alB; bf16x8 pa0, pa1, pa2, pa3; unsigned wA0, wA1, wB0, wB1;
    constexpr int SE = 0, SO = 1;
    MASKW(0, wA0, wA1);
    SLOAD(SE, 0); asm volatile("s_waitcnt vmcnt(0)" ::: "memory"); SWRITE(0, SE); __syncthreads();
    qkt(pA0, pA1, K_lds, qr, r32, hi); partialSM(pA0, pA1, m_reg, mnA, alA, wA0, wA1, tq, na, hi);
    SLOAD(SO, KVBLK); if (2 < NT) SLOAD(SE, 2 * KVBLK);
    asm volatile("s_waitcnt vmcnt(2)" ::: "memory"); SWRITE(1, SO); __syncthreads();
    for (int j = 1; j + 1 < NT; j += 2) {
        MASKW(j, wB0, wB1); asm volatile("s_waitcnt vmcnt(0)" ::: "memory");
        SBAR(); qkt(pB0, pB1, K_lds + SHM_K, qr, r32, hi);
        finishSM(pA0, pA1, alA, l_reg, pa0, pa1, pa2, pa3); SBAR();
        SLOAD(SO, (j + 2) * KVBLK); SBAR();
        pv_d0(o, vb0, pa0, pa1, pa2, pa3); partialSM(pB0, pB1, m_reg, mnB, alB, wB0, wB1, tq - (float)(64 * j), na, hi);
        __syncthreads(); SWAIT(); SWRITE(0, SE);
        RESC(alB); __syncthreads();
        MASKW(j + 1, wA0, wA1);
        SBAR(); qkt(pA0, pA1, K_lds, qr, r32, hi);
        finishSM(pB0, pB1, alB, l_reg, pa0, pa1, pa2, pa3); SBAR();
        if (j + 3 < NT) SLOAD(SE, (j + 3) * KVBLK); SBAR();
        pv_d0(o, vb0 + (int)SHM_V, pa0, pa1, pa2, pa3); partialSM(pA0, pA1, m_reg, mnA, alA, wA0, wA1, tq - (float)(64 * (j + 1)), na, hi);
        __syncthreads(); if (j + 3 < NT) SWAIT(); else asm volatile("s_waitcnt vmcnt(0)" ::: "memory"); SWRITE(1, SO);
        RESC(alA); __syncthreads();
    }
    MASKW(NT - 1, wB0, wB1);
    SBAR(); qkt(pB0, pB1, K_lds + SHM_K, qr, r32, hi);
    finishSM(pA0, pA1, alA, l_reg, pa0, pa1, pa2, pa3); SBAR();
    pv_d0(o, vb0, pa0, pa1, pa2, pa3); partialSM(pB0, pB1, m_reg, mnB, alB, wB0, wB1, tq - (float)(64 * (NT - 1)), na, hi);
    __syncthreads(); RESC(alB);
    finishSM(pB0, pB1, alB, l_reg, pa0, pa1, pa2, pa3); SBAR();
    pv_d0(o, vb0 + (int)SHM_V, pa0, pa1, pa2, pa3);
    if (hi == 0) li_l[r32] = l_reg; asm volatile("s_waitcnt lgkmcnt(0)" ::: "memory");
    float rli[16];
#pragma unroll
    for (int r = 0; r < 16; ++r) rli[r] = __builtin_amdgcn_rcpf(li_l[crow(r, hi)]);
    bf16* Ow = O + ((size_t)b * SEQ + qb * 32) * 1024 + wid * AD;
#pragma unroll
    for (int r = 0; r < 16; ++r) { const int orow = crow(r, hi);
#pragma unroll
        for (int d0 = 0; d0 < 4; ++d0) Ow[(size_t)orow * 1024 + d0 * 32 + r32] = (bf16)(cvtpk(o[d0][r] * rli[r], 0.f) & 0xffffu); }
    __syncthreads();
#undef SLOAD
#undef SWRITE
#undef SWAIT
#undef RESC
#undef MASKW
}
DI void attn_phase(Frame& F) {
#pragma nounroll
    for (int i2 = F.vcu; i2 < 256; i2 += F.G) {
#pragma nounroll
        for (int e = 0; e < 8; ++e) { int b, qb; dsa_unit(i2, e, b, qb); attn_unit(F, b, qb, (char*)(F.lds + RING_OFF)); } }
}

#ifndef PHMASK
#define PHMASK 0xFFFFFFFF
#endif
#define PH(n) (((PHMASK) >> (n)) & 1)
#ifndef FEAT_MIXER
#define FEAT_MIXER 1
#endif
__global__ void __launch_bounds__(NWAVES * 64, 2) fwd_kernel(Args args) {
    extern __shared__ __attribute__((aligned(16))) unsigned char lds[];
    Frame F;
    F.lds = (LAS unsigned char*)lds;
    F.MISC = (volatile LAS unsigned*)(F.lds + MISC_OFF);
    F.wave = __builtin_amdgcn_readfirstlane((int)threadIdx.x >> 6);
    F.G = gridDim.x; { const int bx = blockIdx.x; F.vcu = (F.G % 8 == 0) ? (bx % 8) * (F.G / 8) + bx / 8 : bx; }
    F.ws = args.ws; F.out = args.out;
    F.ctl = (gu32*)(args.ws + WS_CTL);
    for (int u = (int)threadIdx.x; u < (LDS_BYTES - LDSCTL_OFF) / 4; u += NWAVES * 64) ((LAS unsigned*)(F.lds + LDSCTL_OFF))[u] = 0u;
    __syncthreads();
    XcdBarrier bar = xcd_barrier_post((unsigned*)(F.ctl + CW_BAR), F.MISC + 8);
#define GRID_BAR() xcd_barrier(bar)
    using namespace pg8;
    unsigned char* ws = args.ws;
    const int bx = (int)blockIdx.x;
#define LBX() ({ int _b = bx; asm volatile("" : "+s"(_b)); _b; })

    if (PH(0)) p0_prologue(F, args);
    GRID_BAR();
    if (PH(1)) p1_kt(F, args);
    { const float* mod0 = (const float*)(wsl(ws) + WS_MOD);
      if (PH(9)) norm_rows(F, args.in[I_X], nullptr, nullptr, nullptr, nullptr, args.in[I_MIXPRE], mod0 + 1 * DM, mod0 + 0 * DM, (bf16*)(wsl(ws) + WS_H)); }
    GRID_BAR();

    for (int l = 0; l < DEPTH; ++l) {
        const float* mod = (const float*)(wsl(ws) + WS_MOD) + (size_t)l * BATCH * NMOD;
        const float* xin = (l == 0) ? args.in[I_X] : F.out;
#if FEAT_MIXER
        if (PH(2)) s5_expand(F, args, l);
        { Gemm g{(const bf16_t*)(wsl(ws) + WS_H), (const bf16_t*)wslot(F, l, W_IN), MTOK, 4096, DM, DM, DM}; StaticOrder S; S.init(MTOK, 4096, F.G, LBX());
          EpiBf16<0> E{(bf16_t*)(wsl(ws) + WS_ZG), 1024, nullptr, 1024, (size_t)MTOK * 1024, 1.f};
          if (PH(10)) gemm_phase<EpiBf16<0>, StaticOrder, true, true>(F.lds + RING_OFF, g, S, E, F.wave); }
        GRID_BAR();
        if (PH(3)) small_ops(F, args, l);
        GRID_BAR();
        { Gemm g{(const bf16_t*)(wsl(ws) + WS_AS5), (const bf16_t*)(wsl(ws) + WS_WE), 16384, 4096, 1024, AS5_LD, 1024}; GroupOrder<1> S{F.G, LBX()};
          EpiE E{(float*)(wsl(ws) + WS_E)};
          if (PH(11)) gemm_phase<EpiE, GroupOrder<1>, false, true>(F.lds + RING_OFF, g, S, E, F.wave); }
        { Gemm g{(const bf16_t*)(wsl(ws) + WS_POOLED), (const bf16_t*)wslot(F, l, W_POOL), MTOK, 256, 256, 256, 256}; StaticOrder S; S.init(MTOK, 256, F.G, LBX());
          EpiBf16<0> E{(bf16_t*)(wsl(ws) + WS_YP), 256, nullptr, 0, 0, 1.f};
          if (PH(12)) gemm_phase<EpiBf16<0>, StaticOrder, true, true>(F.lds + RING_OFF, g, S, E, F.wave); }
        { Gemm g{(const bf16_t*)(wsl(ws) + WS_CQN), (const bf16_t*)wslot(F, l, W_Q), MTOK, 1280, 256, 256, 256}; StaticOrder S; S.init(MTOK, 1280, F.G, LBX());
          EpiBf16<0> E{(bf16_t*)(wsl(ws) + WS_QQ), 1280, nullptr, 0, 0, 1.f};
          if (PH(13)) gemm_phase<EpiBf16<0>, StaticOrder, true, true>(F.lds + RING_OFF, g, S, E, F.wave); }
        GRID_BAR();
        if (PH(4)) s5_scan(F, l);
        if (PH(5)) indexer_phase(F);
        GRID_BAR();
        { Gemm g{(const bf16_t*)(wsl(ws) + WS_AS5), (const bf16_t*)(wsl(ws) + WS_WY), 16384, 16384, AS5_LD, AS5_LD, AS5_LD}; GroupOrder<4> S{F.G, LBX()};
          EpiS5Y E{(bf16_t*)(wsl(ws) + WS_ZSS)};
          if (PH(14)) gemm_phase<EpiS5Y, GroupOrder<4>, false, true>(F.lds + RING_OFF, g, S, E, F.wave); }
        if (PH(6)) attn_phase(F);
        GRID_BAR();
        { Gemm g{(const bf16_t*)(wsl(ws) + WS_ZSS), (const bf16_t*)wslot(F, l, W_GLU), MTOK, 256, 256, 256, 256}; StaticOrder S; S.init(MTOK, 256, F.G, LBX());
          EpiGlu E{(const bf16_t*)(wsl(ws) + WS_ZSS), (bf16_t*)(wsl(ws) + WS_YS), args.in[I_BGLU] + l * 256};
          if (PH(15)) gemm_phase<EpiGlu, StaticOrder, true, true>(F.lds + RING_OFF, g, S, E, F.wave); }
        GRID_BAR();
        { Gemm g{(const bf16_t*)(wsl(ws) + WS_O), (const bf16_t*)wslot(F, l, W_COMB), MTOK, DM, DM, DM, DM}; StaticOrder S; S.init(MTOK, DM, F.G, LBX());
          EpiGate<false> E{(const bf16_t*)(wsl(ws) + WS_ZG), (bf16_t*)(wsl(ws) + WS_MG)};
          if (PH(16)) gemm_phase<EpiGate<false>, StaticOrder, true, true>(F.lds + RING_OFF, g, S, E, F.wave); }
        { Gemm g{(const bf16_t*)(wsl(ws) + WS_YS), (const bf16_t*)wslot(F, l, W_PB), MTOK, DM, 256, 256, 256}; StaticOrder S; S.init(MTOK, DM, F.G, LBX());
          EpiGate<true> E{(const bf16_t*)(wsl(ws) + WS_ZG) + (size_t)MTOK * 1024, (bf16_t*)(wsl(ws) + WS_MG)};
          if (PH(17)) gemm_phase<EpiGate<true>, StaticOrder, true, true>(F.lds + RING_OFF, g, S, E, F.wave); }
        { Gemm g{(const bf16_t*)(wsl(ws) + WS_YP), (const bf16_t*)wslot(F, l, W_PC), MTOK, DM, 256, 256, 256}; StaticOrder S; S.init(MTOK, DM, F.G, LBX());
          EpiGate<true> E{(const bf16_t*)(wsl(ws) + WS_ZG) + (size_t)2 * MTOK * 1024, (bf16_t*)(wsl(ws) + WS_MG)};
          if (PH(18)) gemm_phase<EpiGate<true>, StaticOrder, true, true>(F.lds + RING_OFF, g, S, E, F.wave); }
        GRID_BAR();
        { Gemm g{(const bf16_t*)(wsl(ws) + WS_MG), (const bf16_t*)wslot(F, l, W_OUT), MTOK, DM, DM, DM, DM}; StaticOrder S; S.init(MTOK, DM, F.G, LBX());
          EpiBf16<0> E{(bf16_t*)(wsl(ws) + WS_Y), DM, nullptr, 0, 0, 1.f};
          if (PH(19)) gemm_phase<EpiBf16<0>, StaticOrder, true, true>(F.lds + RING_OFF, g, S, E, F.wave); }
        GRID_BAR();
        if (PH(9)) norm_rows(F, xin, (const bf16*)(wsl(ws) + WS_Y), mod + 2 * DM, args.in[I_MIXPOST] + l * DM, F.out, args.in[I_FFNPRE] + l * DM, mod + 4 * DM, mod + 3 * DM, (bf16*)(wsl(ws) + WS_H));
        GRID_BAR();
#else
        { const int gw = F.vcu * NWAVES + F.wave, NGW = F.G * NWAVES;
          if (l == 0) for (int m = gw; m < MTOK; m += NGW) { const GAS f32x4* xr = (const GAS f32x4*)(xin + (size_t)m * DM) + lane_id(); GAS f32x4* xo = (GAS f32x4*)(F.out + (size_t)m * DM) + lane_id();
#pragma unroll
              for (int j = 0; j < 4; ++j) xo[64 * j] = xr[64 * j]; } }
        if (PH(9)) norm_rows(F, xin, nullptr, nullptr, nullptr, nullptr, args.in[I_FFNPRE] + l * DM, mod + 4 * DM, mod + 3 * DM, (bf16*)(wsl(ws) + WS_H));
        GRID_BAR();
#endif
        { Gemm g{(const bf16_t*)(wsl(ws) + WS_H), (const bf16_t*)wslot(F, l, W_UP), MTOK, 4096, DM, DM, DM}; StaticOrder S; S.init(MTOK, 4096, F.G, LBX());
          EpiBf16<0> E{(bf16_t*)(wsl(ws) + WS_U), 4096, nullptr, 0, 0, 1.f};
          if (PH(20)) gemm_phase<EpiBf16<0>, StaticOrder, true, true>(F.lds + RING_OFF, g, S, E, F.wave); }
        GRID_BAR();
        if (PH(7)) conv_gate(F, args, l);
        GRID_BAR();
        { Gemm g{(const bf16_t*)(wsl(ws) + WS_A2), (const bf16_t*)wslot(F, l, W_DOWN), MTOK, DM, DFF, DFF, DFF}; StaticOrder S; S.init(MTOK, DM, F.G, LBX());
          EpiBf16<0> E{(bf16_t*)(wsl(ws) + WS_Y), DM, nullptr, 0, 0, 1.f};
          if (PH(21)) gemm_phase<EpiBf16<0>, StaticOrder, true, true>(F.lds + RING_OFF, g, S, E, F.wave); }
        GRID_BAR();
        if (l + 1 < DEPTH) { const float* modn = mod + (size_t)BATCH * NMOD;
            if (PH(9)) norm_rows(F, F.out, (const bf16*)(wsl(ws) + WS_Y), mod + 5 * DM, args.in[I_FFNPOST] + l * DM, F.out, args.in[I_MIXPRE] + (l + 1) * DM, modn + 1 * DM, modn + 0 * DM, (bf16*)(wsl(ws) + WS_H));
            GRID_BAR(); }
        else norm_rows(F, F.out, (const bf16*)(wsl(ws) + WS_Y), mod + 5 * DM, args.in[I_FFNPOST] + l * DM, F.out, nullptr, nullptr, nullptr, nullptr);
    }
}

extern "C" void kernel_launch(void* const* d_in, const int* in_sizes, int n_in, void* d_out, int out_size, void* d_ws, size_t ws_size, hipStream_t stream) {
    static int grid = 0;
    if (grid == 0) {
        if (n_in != N_INPUTS || out_size != MTOK * DM || ws_size < WS_END) { fprintf(stderr, "kernel_launch: unexpected shapes: n_in %d out %d ws %zu (need %zu)\n", n_in, out_size, ws_size, (size_t)WS_END); grid = -1; return; }
        int dev = 0, cus = 0;
        if (hipGetDevice(&dev) != hipSuccess || hipDeviceGetAttribute(&cus, hipDeviceAttributeMultiprocessorCount, dev) != hipSuccess) { grid = -1; return; }
        if (hipFuncSetAttribute((const void*)fwd_kernel, hipFuncAttributeMaxDynamicSharedMemorySize, LDS_BYTES) != hipSuccess) { fprintf(stderr, "kernel_launch: hipFuncSetAttribute failed\n"); grid = -1; return; }
        int per_cu = 0;
        if (hipOccupancyMaxActiveBlocksPerMultiprocessor(&per_cu, (const void*)fwd_kernel, NWAVES * 64, LDS_BYTES) != hipSuccess || per_cu < 1) { fprintf(stderr, "kernel_launch: occupancy query says %d\n", per_cu); }
        (void)hipGetLastError();
        grid = cus;
    }
    if (grid < 0) return;
    (void)hipMemsetAsync((char*)d_ws + WS_CTL, 0, CTL_ZERO_BYTES, stream);
    Args a{};
    for (int i = 0; i < N_INPUTS; ++i) a.in[i] = (const float*)d_in[i];
    a.out = (float*)d_out; a.ws = (unsigned char*)d_ws; a.ph_lo = 0; a.ph_hi = 0; a.li = 0; a.pad = 0;
    hipLaunchKernelGGL(fwd_kernel, dim3(grid), dim3(NWAVES * 64), LDS_BYTES, stream, a);
}
```

```cpp
#include <hip/hip_runtime.h>
#include <cstdio>
#include <cstdint>
#ifndef DOWN_FP8
#define DOWN_FP8 1
#endif
#ifndef UP_FP8
#define UP_FP8 1
#endif
#ifndef IN_FP8
#define IN_FP8 1
#endif
#ifndef OUT_FP8
#define OUT_FP8 1
#endif
#ifndef MERGE_FP8
#define MERGE_FP8 1
#endif
#define Y8_SCALE 4.0f
#ifndef SMALL_FP8
#define SMALL_FP8 1
#endif
#define W8_SCALE 32.0f
namespace pg8 {
#define PG8_LAS __attribute__((address_space(3)))
#define PG8_GAS __attribute__((address_space(1)))
typedef unsigned short bf16_t;
typedef short bf16x8 __attribute__((ext_vector_type(8)));
typedef float f32x4 __attribute__((ext_vector_type(4)));
typedef unsigned u32x4 __attribute__((ext_vector_type(4)));
constexpr int BM = 256, BK = 64, HALF = 128, HTB = HALF * BK * 2  , STAGE_BYTES = 8 * HTB, NXCD = 8, WGM = 8;

__host__ __device__ __forceinline__ int lds_byte(int r, int c) { const int st = (r >> 4) * 2 + (c >> 5), rr = r & 15, cc = c & 31, ob = rr * 64 + cc * 2; return st * 1024 + (ob ^ (((ob >> 9) & 1) << 5)); }
__host__ __device__ __forceinline__ void stage_rc(int b, int& R, int& C) { const int st = b / 1024, sb = b % 1024, swz = sb ^ (((sb >> 9) & 1) << 5); R = (st >> 1) * 16 + swz / 64; C = (st & 1) * 32 + (swz % 64) / 2; }
__host__ __device__ __forceinline__ int perm32(int rho) { const int n = rho >> 4, i = rho & 15; return 8 * (i >> 2) + 4 * n + (i & 3); }

struct Unit { int pm, pn; };
__device__ __forceinline__ float sat8(float x) { return __builtin_amdgcn_fmed3f(x, -448.0f, 448.0f); }
typedef int i32x4_ __attribute__((ext_vector_type(4)));
typedef int i32x8_ __attribute__((ext_vector_type(8)));
__device__ __forceinline__ i32x8_ cat8(bf16x8 lo, bf16x8 hi) { const i32x4_ a = __builtin_bit_cast(i32x4_, lo), b = __builtin_bit_cast(i32x4_, hi); return __builtin_shufflevector(a, b, 0, 1, 2, 3, 4, 5, 6, 7); }
struct Gemm { const bf16_t* A; const bf16_t* Bt; int M, N, K, lda, ldb; };

struct StaticOrder {
    int nM, nN, nwg, G, c;
    __host__ __device__ void init(int M, int N, int G_, int c_) { nM = M / BM; nN = N / BM; nwg = nM * nN; G = G_; c = c_; }
    __host__ __device__ bool next(int i, Unit& u) const {
        const long L = (long)i * G + c; if (L >= nwg) return false;
        int wgid = (int)L; { const int q = nwg / NXCD, r = nwg % NXCD, xcd = wgid % NXCD, off = wgid / NXCD; wgid = (xcd < r ? xcd * (q + 1) : r * (q + 1) + (xcd - r) * q) + off; }
        const int nig = WGM * nN, gid = wgid / nig, fm = gid * WGM, gsz = (nM - fm) < WGM ? (nM - fm) : WGM;
        u.pm = fm + ((wgid % nig) % gsz); u.pn = (wgid % nig) / gsz; return true;
    }
    __device__ __forceinline__ void a_ready(const Unit&) const {}
    __device__ __forceinline__ void done(const Unit&) const {}
};

__device__ __forceinline__ unsigned cvt_pk_bf16(float lo, float hi) { unsigned r; asm volatile("v_cvt_pk_bf16_f32 %0, %1, %2" : "=v"(r) : "v"(lo), "v"(hi)); return r; }
typedef float f32x2 __attribute__((ext_vector_type(2)));
__device__ __forceinline__ f32x2 gelu_pk(f32x2 v) {
    const f32x2 av = __builtin_elementwise_abs(v), d = av * 0.2316418882f + 1.0f;
    f32x2 t; t.x = __builtin_amdgcn_rcpf(d.x); t.y = __builtin_amdgcn_rcpf(d.y);
    f32x2 q = t * 0.5307027145f + (-0.7265760135f); q = q * t + 0.7107068705f; q = q * t + (-0.142248368f); q = q * t + 0.127414796f; q = q * t;
    const f32x2 s = (v * v) * (-0.72134752044f);
    f32x2 e; e.x = __builtin_amdgcn_exp2f(s.x); e.y = __builtin_amdgcn_exp2f(s.y);
    const f32x2 m = v * (q * e), r = v - m;
    f32x2 o; o.x = v.x < 0.f ? m.x : r.x; o.y = v.y < 0.f ? m.y : r.y; return o;
}

typedef __bf16 bf16x2c_ __attribute__((ext_vector_type(2)));
__device__ __forceinline__ unsigned cvt_pk_bf16_c(float lo, float hi) { f32x2 v = {lo, hi}; bf16x2c_ b = __builtin_convertvector(v, bf16x2c_); return __builtin_bit_cast(unsigned, b); }
template <int ACT  > struct EpiBf16 {
    static constexpr bool PERM = true, AFTER_DRAIN = false, MID = false; static_assert(ACT == 0 || ACT == 1 || ACT == 2, "EpiBf16: ACT is 0 (none), 1 (gelu_pk) or 2 (exp(-x) of the scaled value: gate logits stored as E = e^-z, so that sigmoid = 1/(1+E) and gate ratios need no exponentials later)");
    bf16_t* O; int ldc; const float* bias; int split_cols; size_t split_stride; float scale0; float scale_all = 1.f; int plain_t = 1 << 30, plain_col = 0;
    __device__ __forceinline__ void operator()(const f32x4 (&acc)[2][2][4][2], const Unit& u, int wr, int wc, int fr, int fq) const {
        const int row0 = u.pm * BM + wr * 64 + fr; int colt = u.pn * BM; bf16_t* base = O;
        float sc = scale_all; bool act = true; if (split_cols) { const int t = colt / split_cols; base += (size_t)t * split_stride; colt -= t * split_cols; if (t == 0) sc *= scale0; if (t >= plain_t) { colt += plain_col; act = false; } }
        const int col0 = colt + wc * 32 + 8 * fq, bcol0 = u.pn * BM + wc * 32 + 8 * fq;
        f32x4 bv[2][2];
#pragma unroll
        for (int bj = 0; bj < 2; ++bj)
#pragma unroll
            for (int n = 0; n < 2; ++n) bv[bj][n] = bias ? *(const PG8_GAS f32x4*)(bias + bcol0 + bj * HALF + 4 * n) : (f32x4){0.f, 0.f, 0.f, 0.f};
#pragma unroll
        for (int ai = 0; ai < 2; ++ai)
#pragma unroll
            for (int m = 0; m < 4; ++m) { bf16_t* rowp = base + (size_t)(row0 + ai * HALF + m * 16) * ldc + col0;
#pragma unroll
                for (int bj = 0; bj < 2; ++bj) { f32x4 v0 = acc[ai][bj][m][0] + bv[bj][0], v1 = acc[ai][bj][m][1] + bv[bj][1];
                    if (ACT == 1) { f32x2 a = gelu_pk((f32x2){v0[0], v0[1]}), b = gelu_pk((f32x2){v0[2], v0[3]}), c = gelu_pk((f32x2){v1[0], v1[1]}), d = gelu_pk((f32x2){v1[2], v1[3]});
                        v0 = (f32x4){a.x, a.y, b.x, b.y}; v1 = (f32x4){c.x, c.y, d.x, d.y}; }
                    v0 = v0 * sc; v1 = v1 * sc;
                    if (ACT == 2 && act) {
#pragma unroll
                        for (int q = 0; q < 4; ++q) { v0[q] = __builtin_amdgcn_exp2f(-1.4426950408889634f * __builtin_amdgcn_fmed3f(v0[q], -30.0f, 30.0f)); v1[q] = __builtin_amdgcn_exp2f(-1.4426950408889634f * __builtin_amdgcn_fmed3f(v1[q], -30.0f, 30.0f)); } }
                    u32x4 w;
                    if (ACT == 2) { w.x = cvt_pk_bf16_c(v0[0], v0[1]); w.y = cvt_pk_bf16_c(v0[2], v0[3]); w.z = cvt_pk_bf16_c(v1[0], v1[1]); w.w = cvt_pk_bf16_c(v1[2], v1[3]); }
                    else { w.x = cvt_pk_bf16(v0[0], v0[1]); w.y = cvt_pk_bf16(v0[2], v0[3]); w.z = cvt_pk_bf16(v1[0], v1[1]); w.w = cvt_pk_bf16(v1[2], v1[3]); }
                    *(PG8_GAS u32x4*)(rowp + bj * HALF) = w; } }
    }
};
typedef unsigned u32x2h __attribute__((ext_vector_type(2)));
struct EpiF8 {
    static constexpr bool PERM = true, AFTER_DRAIN = false, MID = false;
    unsigned char* O; int ldc; float s;
    __device__ __forceinline__ void operator()(const f32x4 (&acc)[2][2][4][2], const Unit& u, int wr, int wc, int fr, int fq) const {
        const int row0 = u.pm * BM + wr * 64 + fr, col0 = u.pn * BM + wc * 32 + 8 * fq;
#pragma unroll
        for (int ai = 0; ai < 2; ++ai)
#pragma unroll
            for (int m = 0; m < 4; ++m) { unsigned char* rowp = O + (size_t)(row0 + ai * HALF + m * 16) * ldc + col0;
#pragma unroll
                for (int bj = 0; bj < 2; ++bj) { const f32x4 v0 = acc[ai][bj][m][0] * s, v1 = acc[ai][bj][m][1] * s;
                    int p0 = __builtin_amdgcn_cvt_pk_fp8_f32(sat8(v0[0]), sat8(v0[1]), 0, false); p0 = __builtin_amdgcn_cvt_pk_fp8_f32(sat8(v0[2]), sat8(v0[3]), p0, true);
                    int p1 = __builtin_amdgcn_cvt_pk_fp8_f32(sat8(v1[0]), sat8(v1[1]), 0, false); p1 = __builtin_amdgcn_cvt_pk_fp8_f32(sat8(v1[2]), sat8(v1[3]), p1, true);
                    u32x2h w; w.x = (unsigned)p0; w.y = (unsigned)p1; *(PG8_GAS u32x2h*)(rowp + bj * HALF) = w; } }
    }
};

__device__ __forceinline__ float bf_lo(unsigned w) { return __uint_as_float(w << 16); }
__device__ __forceinline__ float bf_hi(unsigned w) { return __uint_as_float(w & 0xffff0000u); }
__device__ __forceinline__ float sigmoidf_(float x) { return __builtin_amdgcn_rcpf(1.0f + __builtin_amdgcn_exp2f(-1.4426950408889634f * x)); }
__device__ __forceinline__ float gelu_tanh(float x) { const float u = x * (1.5957691216057308f + 0.07135481627f * x * x); return x * sigmoidf_(u); }

struct EpiE {
    static constexpr bool PERM = false, AFTER_DRAIN = false, MID = false;
    float* C;
    __device__ __forceinline__ void operator()(const f32x4 (&acc)[2][2][4][2], const Unit& u, int wr, int wc, int fr, int fq) const {
        const int row0 = u.pm * BM + wr * 64 + fr, col0 = wc * 32 + 4 * fq;
#pragma unroll
        for (int ai = 0; ai < 2; ++ai)
#pragma unroll
            for (int m = 0; m < 4; ++m) { float* rowp = C + (size_t)(row0 + ai * HALF + m * 16) * 128 + col0;
#pragma unroll
                for (int n = 0; n < 2; ++n) *(PG8_GAS f32x4*)(rowp + n * 16) = acc[ai][0][m][n]; }
    }
};
struct EpiS5Y {
    static constexpr bool PERM = true, AFTER_DRAIN = false, MID = false;
    bf16_t* ZS;
    __device__ __forceinline__ void operator()(const f32x4 (&acc)[2][2][4][2], const Unit& u, int wr, int wc, int fr, int fq) const {
        int pm_ = u.pm, pn_ = u.pn, fr_ = fr, fq_ = fq; asm volatile("" : "+s"(pm_), "+s"(pn_), "+v"(fr_), "+v"(fq_));
        const int g = pm_ >> 2, i = pm_ & 3, j = pn_ & 3;
        bf16_t* base = ZS + ((size_t)(256 * i + 64 * wr + fr_) * 64 + (16 * j + 2 * wc + (fq_ >> 1))) * 256 + 16 * g + 8 * (fq_ & 1);
#pragma unroll
        for (int ai = 0; ai < 2; ++ai)
#pragma unroll
            for (int m = 0; m < 4; ++m) {
#pragma unroll
                for (int bj = 0; bj < 2; ++bj) {
                    const f32x4 v0 = acc[ai][bj][m][0], v1 = acc[ai][bj][m][1];
                    u32x4 w; w.x = cvt_pk_bf16(gelu_tanh(v0[0]), gelu_tanh(v0[1])); w.y = cvt_pk_bf16(gelu_tanh(v0[2]), gelu_tanh(v0[3]));
                    w.z = cvt_pk_bf16(gelu_tanh(v1[0]), gelu_tanh(v1[1])); w.w = cvt_pk_bf16(gelu_tanh(v1[2]), gelu_tanh(v1[3]));
                    *(PG8_GAS u32x4*)(base + (size_t)((ai * HALF + m * 16) * 64 + bj * 8) * 256) = w; }
                asm volatile("" ::: "memory"); }
    }
};
typedef unsigned u32x2g __attribute__((ext_vector_type(2)));
struct EpiGlu {
    static constexpr bool PERM = true, AFTER_DRAIN = false, MID = false;
    const bf16_t* Zin; bf16_t* O; const float* bias; int ldo;
    __device__ __forceinline__ void operator()(const f32x4 (&acc)[2][2][4][2], const Unit& u, int wr, int wc, int fr, int fq) const {
        const int row0 = u.pm * BM + wr * 64 + fr, col0 = u.pn * BM + wc * 32 + 8 * fq;
#pragma unroll
        for (int bj = 0; bj < 2; ++bj) { const f32x4 b0 = *(const PG8_GAS f32x4*)(bias + col0 + bj * HALF), b1 = *(const PG8_GAS f32x4*)(bias + col0 + bj * HALF + 4);
#pragma unroll
            for (int ai = 0; ai < 2; ++ai)
#pragma unroll
                for (int m = 0; m < 4; ++m) { const size_t off = (size_t)(row0 + ai * HALF + m * 16) * 256 + col0 + bj * HALF;
                    const u32x4 z = *(const PG8_GAS u32x4*)(Zin + off); const f32x4 v0 = acc[ai][bj][m][0] + b0, v1 = acc[ai][bj][m][1] + b1;
                    u32x4 w; w.x = cvt_pk_bf16(bf_lo(z.x) * sigmoidf_(v0[0]), bf_hi(z.x) * sigmoidf_(v0[1])); w.y = cvt_pk_bf16(bf_lo(z.y) * sigmoidf_(v0[2]), bf_hi(z.y) * sigmoidf_(v0[3]));
                    w.z = cvt_pk_bf16(bf_lo(z.z) * sigmoidf_(v1[0]), bf_hi(z.z) * sigmoidf_(v1[1])); w.w = cvt_pk_bf16(bf_lo(z.w) * sigmoidf_(v1[2]), bf_hi(z.w) * sigmoidf_(v1[3]));
                    if (MERGE_FP8) { const float f[8] = {bf_lo(z.x) * sigmoidf_(v0[0]) * Y8_SCALE, bf_hi(z.x) * sigmoidf_(v0[1]) * Y8_SCALE, bf_lo(z.y) * sigmoidf_(v0[2]) * Y8_SCALE, bf_hi(z.y) * sigmoidf_(v0[3]) * Y8_SCALE,
                                                      bf_lo(z.z) * sigmoidf_(v1[0]) * Y8_SCALE, bf_hi(z.z) * sigmoidf_(v1[1]) * Y8_SCALE, bf_lo(z.w) * sigmoidf_(v1[2]) * Y8_SCALE, bf_hi(z.w) * sigmoidf_(v1[3]) * Y8_SCALE};
                        int p0 = __builtin_amdgcn_cvt_pk_fp8_f32(sat8(f[0]), sat8(f[1]), 0, false); p0 = __builtin_amdgcn_cvt_pk_fp8_f32(sat8(f[2]), sat8(f[3]), p0, true); int p1 = __builtin_amdgcn_cvt_pk_fp8_f32(sat8(f[4]), sat8(f[5]), 0, false); p1 = __builtin_amdgcn_cvt_pk_fp8_f32(sat8(f[6]), sat8(f[7]), p1, true);
                        u32x2g w8; w8.x = (unsigned)p0; w8.y = (unsigned)p1; *(PG8_GAS u32x2g*)((unsigned char*)O + (size_t)(row0 + ai * HALF + m * 16) * ldo + col0 + bj * HALF) = w8; }
                    else *(PG8_GAS u32x4*)(O + (size_t)(row0 + ai * HALF + m * 16) * ldo + col0 + bj * HALF) = w; } }
    }
};
typedef unsigned u32x2m __attribute__((ext_vector_type(2)));
#define SIGE(E) __builtin_amdgcn_rcpf(1.0f + (E))
struct EpiMerge {
    static constexpr bool PERM = true, AFTER_DRAIN = false, MID = true;
    static constexpr int T0 = MERGE_FP8 ? 4 : 8, T1 = MERGE_FP8 ? 6 : 12;
    const bf16_t* G; bf16_t* O; size_t gstride; float osc;
    __device__ __forceinline__ void mid(f32x4 (&acc)[2][2][4][2], const Unit& u, int wr, int wc, int fr, int fq, int t) const {
        const bf16_t* Ga = G + (t == T0 ? 0 : gstride); const bf16_t* Gb = Ga + gstride;
        const int row0 = u.pm * BM + wr * 64 + fr, col0 = u.pn * BM + wc * 32 + 8 * fq;
        u32x4 ga[2][2], gb[2][2];
#pragma unroll
        for (int bj = 0; bj < 2; ++bj) { const size_t off = (size_t)row0 * 1024 + col0 + bj * HALF; ga[0][bj] = *(const PG8_GAS u32x4*)(Ga + off); gb[0][bj] = *(const PG8_GAS u32x4*)(Gb + off); }
#pragma unroll
        for (int g = 0; g < 8; ++g) { const int ai = g >> 2, m = g & 3, cb = g & 1, nb = cb ^ 1;
            if (g < 7) { const int ai1 = (g + 1) >> 2, m1 = (g + 1) & 3;
#pragma unroll
                for (int bj = 0; bj < 2; ++bj) { const size_t off = (size_t)(row0 + ai1 * HALF + m1 * 16) * 1024 + col0 + bj * HALF; ga[nb][bj] = *(const PG8_GAS u32x4*)(Ga + off); gb[nb][bj] = *(const PG8_GAS u32x4*)(Gb + off); } }
            asm volatile("" ::: "memory");
#pragma unroll
            for (int bj = 0; bj < 2; ++bj) { const u32x4 xa = ga[cb][bj], xb = gb[cb][bj];
                const float a[8] = {bf_lo(xa.x), bf_hi(xa.x), bf_lo(xa.y), bf_hi(xa.y), bf_lo(xa.z), bf_hi(xa.z), bf_lo(xa.w), bf_hi(xa.w)};
                const float b[8] = {bf_lo(xb.x), bf_hi(xb.x), bf_lo(xb.y), bf_hi(xb.y), bf_lo(xb.z), bf_hi(xb.z), bf_lo(xb.w), bf_hi(xb.w)};
#pragma unroll
                for (int e = 0; e < 8; ++e) { const float ra = (1.0f + b[e]) * __builtin_amdgcn_rcpf(1.0f + a[e]);
                    acc[ai][bj][m][e >> 2][e & 3] *= ra; } }
            asm volatile("" ::: "memory"); }
    }
    __device__ __forceinline__ void operator()(const f32x4 (&acc)[2][2][4][2], const Unit& u, int wr, int wc, int fr, int fq) const {
        const bf16_t* G2 = G + 2 * gstride;
        const int row0 = u.pm * BM + wr * 64 + fr, col0 = u.pn * BM + wc * 32 + 8 * fq;
        u32x4 gq[2][2];
#pragma unroll
        for (int bj = 0; bj < 2; ++bj) gq[0][bj] = *(const PG8_GAS u32x4*)(G2 + (size_t)row0 * 1024 + col0 + bj * HALF);
#pragma unroll
        for (int g = 0; g < 8; ++g) { const int ai = g >> 2, m = g & 3, cb = g & 1, nb = cb ^ 1;
            if (g < 7) { const int ai1 = (g + 1) >> 2, m1 = (g + 1) & 3;
#pragma unroll
                for (int bj = 0; bj < 2; ++bj) gq[nb][bj] = *(const PG8_GAS u32x4*)(G2 + (size_t)(row0 + ai1 * HALF + m1 * 16) * 1024 + col0 + bj * HALF); }
            asm volatile("" ::: "memory");
#pragma unroll
            for (int bj = 0; bj < 2; ++bj) { const size_t off = (size_t)(row0 + ai * HALF + m * 16) * 1024 + col0 + bj * HALF;
                const u32x4 gl = gq[cb][bj]; const f32x4 v0 = acc[ai][bj][m][0] * osc, v1 = acc[ai][bj][m][1] * osc;
                if (OUT_FP8) { const float f[8] = {SIGE(bf_lo(gl.x)) * v0[0], SIGE(bf_hi(gl.x)) * v0[1], SIGE(bf_lo(gl.y)) * v0[2], SIGE(bf_hi(gl.y)) * v0[3], SIGE(bf_lo(gl.z)) * v1[0], SIGE(bf_hi(gl.z)) * v1[1], SIGE(bf_lo(gl.w)) * v1[2], SIGE(bf_hi(gl.w)) * v1[3]};
                    int p0 = __builtin_amdgcn_cvt_pk_fp8_f32(sat8(f[0]), sat8(f[1]), 0, false); p0 = __builtin_amdgcn_cvt_pk_fp8_f32(sat8(f[2]), sat8(f[3]), p0, true); int p1 = __builtin_amdgcn_cvt_pk_fp8_f32(sat8(f[4]), sat8(f[5]), 0, false); p1 = __builtin_amdgcn_cvt_pk_fp8_f32(sat8(f[6]), sat8(f[7]), p1, true);
                    u32x2m w8; w8.x = (unsigned)p0; w8.y = (unsigned)p1; *(PG8_GAS u32x2m*)((unsigned char*)O + off) = w8; }
                else {
                u32x4 w; w.x = cvt_pk_bf16(SIGE(bf_lo(gl.x)) * v0[0], SIGE(bf_hi(gl.x)) * v0[1]); w.y = cvt_pk_bf16(SIGE(bf_lo(gl.y)) * v0[2], SIGE(bf_hi(gl.y)) * v0[3]);
                w.z = cvt_pk_bf16(SIGE(bf_lo(gl.z)) * v1[0], SIGE(bf_hi(gl.z)) * v1[1]); w.w = cvt_pk_bf16(SIGE(bf_lo(gl.w)) * v1[2], SIGE(bf_hi(gl.w)) * v1[3]);
                *(PG8_GAS u32x4*)(O + off) = w; } }
            asm volatile("" ::: "memory"); }
    }
};
__device__ __forceinline__ float dpp_shr1(float v) { return __int_as_float(__builtin_amdgcn_update_dpp(0, __float_as_int(v), 0x111, 0xf, 0xf, true)); }
typedef unsigned u32x2e __attribute__((ext_vector_type(2)));
struct EpiConv {
    static constexpr bool PERM = true, AFTER_DRAIN = false, MID = false;
    const float* cw; const float* cb; bf16_t* A2; float* HALO; float usc;
    __device__ __forceinline__ void operator()(const f32x4 (&acc)[2][2][4][2], const Unit& u, int wr, int wc, int fr, int fq) const {
        int pm_ = u.pm, pn_ = u.pn; asm volatile("" : "+s"(pm_), "+s"(pn_));
        const int j0 = pn_ * 128 + wc * 32 + 8 * fq, tok0 = pm_ * BM + wr * 128 + fr * 8;
        float* hb = HALO + (size_t)(pm_ * 2 + wr) * 4 * 4096 + j0;
        if (fr == 0) {
#pragma unroll
            for (int bj = 0; bj < 2; ++bj)
#pragma unroll
                for (int n = 0; n < 2; ++n) { *(PG8_GAS f32x4*)(hb + 0 * 4096 + bj * 2048 + 4 * n) = acc[0][bj][0][n]; *(PG8_GAS f32x4*)(hb + 1 * 4096 + bj * 2048 + 4 * n) = acc[0][bj][1][n]; } }
        if (fr == 15) {
#pragma unroll
            for (int bj = 0; bj < 2; ++bj)
#pragma unroll
                for (int n = 0; n < 2; ++n) { *(PG8_GAS f32x4*)(hb + 2 * 4096 + bj * 2048 + 4 * n) = acc[1][bj][2][n]; *(PG8_GAS f32x4*)(hb + 3 * 4096 + bj * 2048 + 4 * n) = acc[1][bj][3][n]; } }
        unsigned pk[8][4];
#pragma unroll
        for (int n = 0; n < 2; ++n) {
            f32x4 w0g = *(const PG8_GAS f32x4*)(cw + j0 + 4 * n), w1g = *(const PG8_GAS f32x4*)(cw + 4096 + j0 + 4 * n), w2g = *(const PG8_GAS f32x4*)(cw + 8192 + j0 + 4 * n); const f32x4 bg = *(const PG8_GAS f32x4*)(cb + j0 + 4 * n);
            f32x4 w0v = *(const PG8_GAS f32x4*)(cw + 2048 + j0 + 4 * n), w1v = *(const PG8_GAS f32x4*)(cw + 4096 + 2048 + j0 + 4 * n), w2v = *(const PG8_GAS f32x4*)(cw + 8192 + 2048 + j0 + 4 * n); const f32x4 bv = *(const PG8_GAS f32x4*)(cb + 2048 + j0 + 4 * n);
            if (UP_FP8) { w0g = w0g * usc; w1g = w1g * usc; w2g = w2g * usc; w0v = w0v * usc; w1v = w1v * usc; w2v = w2v * usc; }
#pragma unroll
            for (int i2 = 0; i2 < 2; ++i2) {
                float outp[2][8];
#pragma unroll
                for (int ii = 0; ii < 2; ++ii) { const int i = 2 * i2 + ii;
                    float G[8], V[8];
#pragma unroll
                    for (int e = 0; e < 8; ++e) { G[e] = acc[e >> 2][0][e & 3][n][i]; V[e] = acc[e >> 2][1][e & 3][n][i]; }
                    const float gm1 = dpp_shr1(G[7]), gm2 = dpp_shr1(G[6]), vm1 = dpp_shr1(V[7]), vm2 = dpp_shr1(V[6]);
#pragma unroll
                    for (int e = 0; e < 8; ++e) {
                        const float ga = (e >= 2) ? G[e >= 2 ? e - 2 : 0] : (e == 0 ? gm2 : gm1), gb = (e >= 1) ? G[e >= 1 ? e - 1 : 0] : gm1;
                        const float va = (e >= 2) ? V[e >= 2 ? e - 2 : 0] : (e == 0 ? vm2 : vm1), vb = (e >= 1) ? V[e >= 1 ? e - 1 : 0] : vm1;
                        const float cg = bg[i] + w0g[i] * ga + w1g[i] * gb + w2g[i] * G[e], cv = bv[i] + w0v[i] * va + w1v[i] * vb + w2v[i] * V[e];
                        outp[ii][e] = gelu_tanh(cg) * cv; } }
#pragma unroll
                for (int e = 0; e < 8; ++e) { if (DOWN_FP8) { if (i2 == 0) pk[e][n] = (unsigned)__builtin_amdgcn_cvt_pk_fp8_f32(sat8(outp[0][e]), sat8(outp[1][e]), 0, false); else pk[e][n] = (unsigned)__builtin_amdgcn_cvt_pk_fp8_f32(sat8(outp[0][e]), sat8(outp[1][e]), (int)pk[e][n], true); }
                    else pk[e][2 * n + i2] = cvt_pk_bf16(outp[0][e], outp[1][e]); }
            }
        }
#pragma unroll
        for (int e = 0; e < 8; ++e) { if (DOWN_FP8) { u32x2e w; w.x = pk[e][0]; w.y = pk[e][1]; *(PG8_GAS u32x2e*)((unsigned char*)A2 + (size_t)(tok0 + e) * 2048 + j0) = w; }
            else { u32x4 w; w.x = pk[e][0]; w.y = pk[e][1]; w.z = pk[e][2]; w.w = pk[e][3]; *(PG8_GAS u32x4*)(A2 + (size_t)(tok0 + e) * 2048 + j0) = w; } }
    }
};
struct PanelOrder {
    int pm, n, rot = 0;
    __device__ __forceinline__ bool next(int i, Unit& u) const { if (i >= n) return false; int p = pm; asm volatile("" : "+s"(p)); u.pm = p; u.pn = (i + rot) & (n - 1); return true; }
    __device__ __forceinline__ void a_ready(const Unit&) const {}
    __device__ __forceinline__ void done(const Unit&) const {}
};
struct QQOrder {
    int G, c;
    __device__ __forceinline__ bool next(int i, Unit& u) const {
        if (G != 256) { const int L = i * G + c; if (L >= 1280) return false; u.pm = L / 5; u.pn = L % 5; return true; }
        int L; if (c >= 64) { if (i >= 6) return false; L = (c - 64) * 6 + i; } else { if (i >= 2) return false; L = 1152 + c * 2 + i; }
        u.pm = L / 5; u.pn = L % 5; return true; }
    __device__ __forceinline__ void a_ready(const Unit&) const {}
    __device__ __forceinline__ void done(const Unit&) const {}
};
template <int NJ> struct GroupOrder {
    int G, c;
    __device__ __forceinline__ bool next(int i, Unit& u) const { const int L = i * G + c; if (L >= 16 * 4 * NJ) return false; const int g = L / (4 * NJ), r = L % (4 * NJ); u.pm = 4 * g + r / NJ; u.pn = NJ * g + r % NJ; return true; }
    __device__ __forceinline__ void a_ready(const Unit&) const {}
    __device__ __forceinline__ void done(const Unit&) const {}
};
template <class Epi, class Sched, bool ALIGN_EPI = false, bool SP2 = false, bool FP8 = false>
__device__ __forceinline__ void gemm_phase(PG8_LAS unsigned char* lds, const Gemm g, const Sched& S, const Epi& E, const int wave_in) {
    int lane_; asm volatile("v_mbcnt_lo_u32_b32 %0, -1, 0\n\tv_mbcnt_hi_u32_b32 %0, -1, %0" : "=v"(lane_));
    const int wid = wave_in, lane = lane_, tid = wid * 64 + lane, wr = wid >> 2, wc = wid & 3, fr = lane & 15, fq = lane >> 4;
    const int K = g.K, nt = K / BK, lda = g.lda, ldb = g.ldb;
    unsigned voffA[2], voffB[2];
#pragma unroll
    for (int i = 0; i < 2; ++i) { int R, C; stage_rc(tid * 16 + i * 8192, R, C); const int Rb = Epi::PERM ? ((R & ~31) + perm32(R & 31)) : R;
        voffA[i] = (unsigned)(R * lda + C) * 2u; voffB[i] = (unsigned)(Rb * ldb + C) * 2u; }
    const size_t kstep = (size_t)(BK * 2);
    const size_t hstepA = (size_t)HALF * lda * 2, hstepB = (size_t)HALF * ldb * 2;
    const size_t tstepA = 2 * hstepA, tstepB = 2 * hstepB;
    const unsigned ldsw = (unsigned)wid * 1024u;
    const int aoff = lds_byte(wr * 64 + fr, fq * 8), boff = lds_byte(wc * 32 + fr, fq * 8);
#define PG8_SA(b, h) (((b) * 2 + (h)) * HTB)
#define PG8_SB(b, h) ((4 + (b) * 2 + (h)) * HTB)
#define PG8_STAGE(bufoff, gbase, voff) do { _Pragma("unroll") for (int _i = 0; _i < 2; ++_i) { unsigned _v = (voff)[_i]; asm volatile("" : "+v"(_v));     \
        __builtin_amdgcn_global_load_lds((const unsigned*)((const char*)(gbase) + _v), (PG8_LAS unsigned*)(lds + (bufoff) + ldsw + _i * 8192), 16, 0, 0); } } while (0)
#define PG8_LDA(dst, b, h) do { _Pragma("unroll") for (int m = 0; m < 4; ++m) _Pragma("unroll") for (int k = 0; k < 2; ++k) dst[m][k] = *(const PG8_LAS bf16x8*)(lds + PG8_SA(b, h) + aoff + m * 2048 + k * 1024); } while (0)
#define PG8_LDB(dst, b, h) do { _Pragma("unroll") for (int n = 0; n < 2; ++n) _Pragma("unroll") for (int k = 0; k < 2; ++k) dst[n][k] = *(const PG8_LAS bf16x8*)(lds + PG8_SB(b, h) + boff + n * 2048 + k * 1024); } while (0)
#define PG8_MMA(ai, bj, At, Bt) do { __builtin_amdgcn_s_setprio(1); _Pragma("unroll") for (int m = 0; m < 4; ++m) _Pragma("unroll") for (int n = 0; n < 2; ++n) { \
        if constexpr (FP8) acc[ai][bj][m][n] = __builtin_amdgcn_mfma_scale_f32_16x16x128_f8f6f4(cat8(Bt[n][0], Bt[n][1]), cat8(At[m][0], At[m][1]), acc[ai][bj][m][n], 0, 0, 0, 0, 0, 0); \
        else { _Pragma("unroll") for (int k = 0; k < 2; ++k) acc[ai][bj][m][n] = __builtin_amdgcn_mfma_f32_16x16x32_bf16(Bt[n][k], At[m][k], acc[ai][bj][m][n], 0, 0, 0); } } __builtin_amdgcn_s_setprio(0); } while (0)
#define PG8_WAIT_V(n) asm volatile("s_waitcnt vmcnt(" #n ")" ::: "memory")
#define PG8_WAIT_L(n) asm volatile("s_waitcnt lgkmcnt(" #n ")" ::: "memory")
#define PG8_BAR __builtin_amdgcn_s_barrier()
#define PG8_SCHED __builtin_amdgcn_sched_barrier(0)
    Unit cur, nxt; int ui = 0;
    if (!S.next(0, cur)) return;
    f32x4 acc[2][2][4][2];
#pragma unroll
    for (int a = 0; a < 2; ++a)
#pragma unroll
        for (int b = 0; b < 2; ++b)
#pragma unroll
            for (int m = 0; m < 4; ++m)
#pragma unroll
                for (int n = 0; n < 2; ++n) acc[a][b][m][n] = (f32x4){0.f, 0.f, 0.f, 0.f};
    bf16x8 At[4][2], B0[2][2], B1[2][2];
    const char* cA = (const char*)g.A + (size_t)cur.pm * tstepA; const char* cB = (const char*)g.Bt + (size_t)cur.pn * tstepB;
    S.a_ready(cur);
    if constexpr (SP2) {
        PG8_STAGE(PG8_SB(0, 0), cB, voffB); PG8_STAGE(PG8_SB(0, 1), cB + hstepB, voffB); PG8_STAGE(PG8_SA(0, 0), cA, voffA); PG8_STAGE(PG8_SA(0, 1), cA + hstepA, voffA);
        if (wr == 1) PG8_BAR;
        PG8_WAIT_V(2); PG8_BAR;
        PG8_STAGE(PG8_SB(1, 0), cB + kstep, voffB); PG8_STAGE(PG8_SA(1, 0), cA + kstep, voffA); PG8_STAGE(PG8_SB(1, 1), cB + hstepB + kstep, voffB);
        PG8_WAIT_V(6); PG8_BAR;
    } else {
        PG8_STAGE(PG8_SB(0, 0), cB, voffB); PG8_STAGE(PG8_SA(0, 0), cA, voffA); PG8_STAGE(PG8_SB(0, 1), cB + hstepB, voffB); PG8_STAGE(PG8_SA(0, 1), cA + hstepA, voffA);
        if (wr == 1) PG8_BAR;
        PG8_WAIT_V(4); PG8_BAR;
        PG8_STAGE(PG8_SB(1, 0), cB + kstep, voffB); PG8_STAGE(PG8_SA(1, 0), cA + kstep, voffA); PG8_STAGE(PG8_SB(1, 1), cB + hstepB + kstep, voffB);
        PG8_WAIT_V(6); PG8_BAR;
    }
    for (;;) {
        const bool has_next = S.next(ui + 1, nxt);
        const char* nA = has_next ? (const char*)g.A + (size_t)nxt.pm * tstepA : cA; const char* nB = has_next ? (const char*)g.Bt + (size_t)nxt.pn * tstepB : cB;
#pragma nounroll
        for (int t = 0; t < nt; t += 2) {
            const bool last = (t == nt - 2);
            const char* a1 = cA + (size_t)(t + 1) * kstep;
            const char* a2 = last ? nA : cA + (size_t)(t + 2) * kstep; const char* b2 = last ? nB : cB + (size_t)(t + 2) * kstep;
            const char* a3 = a2 + kstep; const char* b3 = b2 + kstep;
            if (last && has_next) S.a_ready(nxt);
            if constexpr (Epi::MID) { if (t == Epi::T0 || t == Epi::T1) { int lm_; asm volatile("v_mbcnt_lo_u32_b32 %0, -1, 0\n\tv_mbcnt_hi_u32_b32 %0, -1, %0" : "=v"(lm_)); E.mid(acc, cur, wr, wc, lm_ & 15, lm_ >> 4, t); } }
            if constexpr (SP2) {
            PG8_LDB(B0, 0, 0); PG8_LDB(B1, 0, 1); PG8_SCHED; PG8_LDA(At, 0, 0); PG8_STAGE(PG8_SA(1, 1), a1 + hstepA, voffA);
            PG8_WAIT_V(8); PG8_WAIT_L(0); PG8_BAR; PG8_MMA(0, 0, At, B0); PG8_MMA(0, 1, At, B1); PG8_BAR; PG8_SCHED;
            PG8_LDA(At, 0, 1); PG8_STAGE(PG8_SB(0, 0), b2, voffB); PG8_STAGE(PG8_SB(0, 1), b2 + hstepB, voffB); PG8_STAGE(PG8_SA(0, 0), a2, voffA);
            PG8_WAIT_V(8); PG8_WAIT_L(0); PG8_BAR; PG8_MMA(1, 0, At, B0); PG8_MMA(1, 1, At, B1); PG8_BAR; PG8_SCHED;
            PG8_LDB(B0, 1, 0); PG8_LDB(B1, 1, 1); PG8_SCHED; PG8_LDA(At, 1, 0); PG8_STAGE(PG8_SA(0, 1), a2 + hstepA, voffA);
            PG8_WAIT_V(8); PG8_WAIT_L(0); PG8_BAR; PG8_MMA(0, 0, At, B0); PG8_MMA(0, 1, At, B1); PG8_BAR; PG8_SCHED;
            PG8_LDA(At, 1, 1); PG8_STAGE(PG8_SB(1, 0), b3, voffB); PG8_STAGE(PG8_SB(1, 1), b3 + hstepB, voffB); PG8_STAGE(PG8_SA(1, 0), a3, voffA);
            PG8_WAIT_V(8); PG8_WAIT_L(0); PG8_BAR; PG8_MMA(1, 0, At, B0); PG8_MMA(1, 1, At, B1); PG8_BAR; PG8_SCHED;
            } else {
            PG8_LDB(B0, 0, 0); PG8_SCHED; PG8_LDA(At, 0, 0); PG8_STAGE(PG8_SA(1, 1), a1 + hstepA, voffA);
            PG8_WAIT_L(8); PG8_BAR; PG8_WAIT_L(0); PG8_MMA(0, 0, At, B0); PG8_BAR; PG8_SCHED;
            PG8_LDB(B1, 0, 1); PG8_STAGE(PG8_SB(0, 0), b2, voffB);
            PG8_BAR; PG8_WAIT_L(0); PG8_MMA(0, 1, At, B1); PG8_BAR;
            PG8_LDA(At, 0, 1); PG8_STAGE(PG8_SA(0, 0), a2, voffA);
            PG8_BAR; PG8_WAIT_L(0); PG8_MMA(1, 0, At, B0); PG8_BAR; PG8_SCHED;
            PG8_STAGE(PG8_SB(0, 1), b2 + hstepB, voffB);
            PG8_WAIT_V(6); PG8_BAR; PG8_MMA(1, 1, At, B1); PG8_BAR;
            PG8_LDB(B0, 1, 0); PG8_SCHED; PG8_LDA(At, 1, 0); PG8_STAGE(PG8_SA(0, 1), a2 + hstepA, voffA);
            PG8_WAIT_L(8); PG8_BAR; PG8_WAIT_L(0); PG8_MMA(0, 0, At, B0); PG8_BAR; PG8_SCHED;
            PG8_LDB(B1, 1, 1); PG8_STAGE(PG8_SB(1, 0), b3, voffB);
            PG8_BAR; PG8_WAIT_L(0); PG8_MMA(0, 1, At, B1); PG8_BAR;
            PG8_LDA(At, 1, 1); PG8_STAGE(PG8_SA(1, 0), a3, voffA);
            PG8_BAR; PG8_WAIT_L(0); PG8_MMA(1, 0, At, B0); PG8_BAR; PG8_SCHED;
            PG8_STAGE(PG8_SB(1, 1), b3 + hstepB, voffB);
            PG8_WAIT_V(6); PG8_BAR; PG8_MMA(1, 1, At, B1); PG8_BAR;
            }
        }
        if constexpr (ALIGN_EPI) { if (wr == 0) PG8_BAR; }
        if constexpr (!Epi::AFTER_DRAIN) { int le_; asm volatile("v_mbcnt_lo_u32_b32 %0, -1, 0\n\tv_mbcnt_hi_u32_b32 %0, -1, %0" : "=v"(le_));
            E(acc, cur, wr, wc, le_ & 15, le_ >> 4); S.done(cur); }
        if (!has_next) break;
#pragma unroll
        for (int a = 0; a < 2; ++a)
#pragma unroll
            for (int b = 0; b < 2; ++b)
#pragma unroll
                for (int m = 0; m < 4; ++m)
#pragma unroll
                    for (int n = 0; n < 2; ++n) acc[a][b][m][n] = (f32x4){0.f, 0.f, 0.f, 0.f};
        cur = nxt; cA = nA; cB = nB; ++ui;
        if constexpr (ALIGN_EPI) { if (wr == 1) PG8_BAR; }
    }
    PG8_WAIT_V(0);
    if constexpr (!ALIGN_EPI) { if (wr == 0) PG8_BAR; }
    PG8_BAR;
    if constexpr (Epi::AFTER_DRAIN) { E.fused(acc, cur, wr, wc, fr, fq, lds, wid, lane); S.done(cur); }
#undef PG8_SA
#undef PG8_SB
#undef PG8_STAGE
#undef PG8_LDA
#undef PG8_LDB
#undef PG8_MMA
#undef PG8_WAIT_V
#undef PG8_WAIT_L
#undef PG8_BAR
#undef PG8_SCHED
}
}
#define GAS __attribute__((address_space(1)))
#define LAS __attribute__((address_space(3)))
typedef unsigned short bf16;
typedef unsigned v4u __attribute__((ext_vector_type(4)));
typedef float f32x4 __attribute__((ext_vector_type(4)));
typedef short bf16x8 __attribute__((ext_vector_type(8)));
typedef GAS unsigned gu32;
typedef GAS unsigned long long gu64;
#define RLX_AGENT __ATOMIC_RELAXED, __HIP_MEMORY_SCOPE_AGENT
#define LDS_WAIT() asm volatile("s_waitcnt lgkmcnt(0)" ::: "memory")
#define VM_WAIT() asm volatile("s_waitcnt vmcnt(0)" ::: "memory")
__device__ __forceinline__ unsigned long long rt() { return __builtin_amdgcn_s_memrealtime(); }
__device__ __forceinline__ unsigned f2bf(float f) { unsigned u = __builtin_bit_cast(unsigned, f); return (u + 0x7fffu + ((u >> 16) & 1u)) >> 16; }
__device__ __forceinline__ unsigned pk2(float lo, float hi) { return f2bf(lo) | (f2bf(hi) << 16); }

#define XB_TMO      128
#define XB_XCNT(j)  (256  + 64 * (j))
#define XB_XSUB(j)  (1280 + 64 * (j))
#define XB_XGEN(j)  (2304 + 64 * (j))
#define XB_TOP      3328
#define XB_TOPGEN   3392
#define XCD_BAR_WORDS 3456
#define XB_SPIN_CAP (1u << 18)

__device__ __forceinline__ unsigned xb_ld(unsigned* p)              { return __hip_atomic_load(p, __ATOMIC_RELAXED, __HIP_MEMORY_SCOPE_AGENT); }
__device__ __forceinline__ unsigned xb_add(unsigned* p, unsigned v) { return __hip_atomic_fetch_add(p, v, __ATOMIC_RELAXED, __HIP_MEMORY_SCOPE_AGENT); }
__device__ __forceinline__ unsigned xb_xcc_id() { return (unsigned)__builtin_amdgcn_s_getreg((3 << 11) | 20) & 0xFu; }
#define XB_SPIN(cond, bar) do { unsigned _sp = 0; while (cond) { __builtin_amdgcn_s_sleep(1); \
    if ((++_sp & 255u) == 0u) { if (xb_ld(&(bar)[XB_TMO])) break; if (_sp > XB_SPIN_CAP) { atomicAdd(&(bar)[XB_TMO], 1u); break; } } } } while (0)

__device__ __forceinline__ int xb_lane() { int l; asm volatile("v_mbcnt_lo_u32_b32 %0, -1, 0\n\tv_mbcnt_hi_u32_b32 %0, -1, %0" : "=v"(l)); return l; }
struct XcdBarrier {
    unsigned* bar; unsigned x; int wave;
    volatile LAS unsigned* st;
};

__device__ __forceinline__ XcdBarrier xcd_barrier_post(unsigned* bar, volatile LAS unsigned* st) {
    XcdBarrier b; b.bar = bar; b.x = xb_xcc_id(); b.st = st; b.wave = 0;
    if (threadIdx.x == 0) (void)xb_add(&bar[XB_XCNT(b.x)], 1u);
    return b;
}
__device__ __forceinline__ void xcd_barrier_complete(unsigned* bar, unsigned x, unsigned& nloc, unsigned& nx) {
    const unsigned G = gridDim.x * gridDim.y * gridDim.z;
    unsigned sum, cnt, mine, sp = 0u;
    for (;;) {
        sum = 0u; cnt = 0u; mine = 0u;
#pragma unroll
        for (unsigned j = 0; j < 16; ++j) { const unsigned c = xb_ld(&bar[XB_XCNT(j)]); sum += c; cnt += (c > 0u) ? 1u : 0u; mine = (j == x) ? c : mine; }
        if (sum == G) break;
        __builtin_amdgcn_s_sleep(1);
        if ((++sp & 255u) == 0u) { if (xb_ld(&bar[XB_TMO])) break; if (sp > XB_SPIN_CAP) { atomicAdd(&bar[XB_TMO], 1u); break; } }
    }
    nloc = mine > 0u ? mine : 1u; nx = cnt > 0u ? cnt : 1u;
}

__device__ __forceinline__ void xcd_barrier(const XcdBarrier& b) {
    asm volatile("s_waitcnt vmcnt(0)" ::: "memory");
    __syncthreads();
    if (b.wave == 0 && xb_lane() == 0) {
        unsigned* bar = b.bar; asm volatile("" : "+s"(bar));
        __builtin_amdgcn_s_waitcnt(0);
        unsigned nloc = b.st[0], nx = b.st[1];
        if (nloc == 0u) { xcd_barrier_complete(bar, b.x, nloc, nx); b.st[0] = nloc; b.st[1] = nx; }
        const unsigned old = xb_add(&bar[XB_XSUB(b.x)], 1u);
        const unsigned gen = old / nloc;
        if (old + 1u == (gen + 1u) * nloc) {
            __builtin_amdgcn_fence(__ATOMIC_RELEASE, "agent");
            asm volatile("s_waitcnt vmcnt(0)" ::: "memory");
            const unsigned og = xb_add(&bar[XB_TOP], 1u);
            const unsigned tg = og / nx;
            if (og + 1u == (tg + 1u) * nx) xb_add(&bar[XB_TOPGEN], 1u);
            else XB_SPIN(xb_ld(&bar[XB_TOPGEN]) == tg, bar);
            __builtin_amdgcn_fence(__ATOMIC_ACQUIRE, "agent");
            xb_add(&bar[XB_XGEN(b.x)], 1u);
            asm volatile("s_waitcnt vmcnt(0)" ::: "memory");
        } else {
            XB_SPIN(xb_ld(&bar[XB_XGEN(b.x)]) == gen, bar);
            __builtin_amdgcn_fence(__ATOMIC_ACQUIRE, "agent");
            asm volatile("s_waitcnt vmcnt(0)" ::: "memory");
        }
    }
    __syncthreads();
}

#define DI __device__ __forceinline__
constexpr int NWAVES = 8;
constexpr int BATCH = 32, SEQ = 2048, DM = 1024, MTOK = BATCH * SEQ, DEPTH = 2;
constexpr int NIN = 4008, DFF = 2048, NMOD = 6 * DM;
constexpr float RMS_EPS = 1e-6f;
constexpr size_t MiB = 1u << 20;
constexpr size_t WS_CTL = 0, CTL_ZERO_BYTES = 1 * MiB;
constexpr size_t WS_MOD = 1 * MiB;
constexpr size_t WS_LAMJ = 3 * MiB;
constexpr size_t WS_BBAR = 5 * MiB;
constexpr size_t WS_KT = 6 * MiB;
constexpr size_t WS_W = 8 * MiB, W_SLOT = 28 * MiB;
constexpr size_t W_IN = 0, W_UP = 8 * MiB, W_DOWN = 16 * MiB, W_M = 20 * MiB, W_OUT = 22 * MiB, W_Q = 24 * MiB, W_UVF = 25 * MiB, W_GLU = 26 * MiB, W_POOL = 26 * MiB + 128 * 1024;
constexpr size_t WS_WY = 64 * MiB;
constexpr size_t WS_WE = 100 * MiB;
constexpr size_t WS_ZG = 108 * MiB;
constexpr size_t WS_ZS = 492 * MiB;
constexpr size_t WS_YC = WS_ZS;
constexpr size_t WS_QQ = 620 * MiB;
constexpr size_t WS_MG = WS_QQ;
constexpr size_t WS_H8 = WS_QQ;
constexpr size_t WS_H = 780 * MiB;
constexpr size_t WS_CQN = 780 * MiB, WS_CKVN = 812 * MiB, WS_AS5 = 828 * MiB, WS_POOLED = 864 * MiB, WS_E = 896 * MiB, WS_KI = 904 * MiB;
constexpr size_t WS_SELQ = 908 * MiB, WS_ZSS = 924 * MiB, WS_YS = 956 * MiB, WS_YP = 988 * MiB, WS_WI = 1020 * MiB, WS_END = 1022 * MiB;
constexpr size_t WS_Y = 108 * MiB;
constexpr size_t WS_U = 108 * MiB;
constexpr size_t WS_HALO = 108 * MiB;
constexpr size_t WS_A2 = 140 * MiB;
constexpr size_t WS_Y2 = 400 * MiB;
constexpr int AS5_LD = 1152;
constexpr int CW_BAR = 4096;
constexpr int RING_OFF = 0, RING_BYTES = 131072, LDSCTL_OFF = RING_BYTES, MISC_OFF = LDSCTL_OFF + 320, LDS_BYTES = 147456;

enum { I_X = 0, I_C, I_MODW, I_MODB, I_MIXPRE, I_MIXPOST, I_FFNPRE, I_FFNPOST, I_WIN, I_GCQ, I_WUQ, I_WQI, I_GCKV, I_WUV, I_ARE, I_AIM, I_BRE, I_BIM, I_CRE, I_CIM,
       I_DSKIP, I_LOGSTEP, I_WGLU, I_BGLU, I_WPOOL, I_PSCALE, I_PA, I_PB, I_PC, I_WOUT, I_WUP, I_CONVW, I_CONVB, I_WDOWN, N_INPUTS };
struct Args { const float* in[N_INPUTS]; float* out; unsigned char* ws; int ph_lo, ph_hi, li, pad; };

typedef float f32x2v __attribute__((ext_vector_type(2)));
typedef unsigned u32x2v __attribute__((ext_vector_type(2)));
struct Frame {
    LAS unsigned char* lds;
    volatile LAS unsigned* MISC;
    gu32* ctl;
    int wave, vcu, G;
    unsigned char* ws;
    float* out;
};
DI unsigned char* wsl(unsigned char* p) { asm volatile("" : "+s"(p)); return p; }
DI int lane_id() { int l; asm volatile("v_mbcnt_lo_u32_b32 %0, -1, 0\n\tv_mbcnt_hi_u32_b32 %0, -1, %0" : "=v"(l)); return l; }
DI float wave_sum(float v, int) {
    v += __int_as_float(__builtin_amdgcn_update_dpp(0, __float_as_int(v), 0xB1, 0xf, 0xf, true));
    v += __int_as_float(__builtin_amdgcn_update_dpp(0, __float_as_int(v), 0x4E, 0xf, 0xf, true));
    v += __int_as_float(__builtin_amdgcn_update_dpp(0, __float_as_int(v), 0x141, 0xf, 0xf, true));
    v += __int_as_float(__builtin_amdgcn_update_dpp(0, __float_as_int(v), 0x140, 0xf, 0xf, true));
    v += __int_as_float(__builtin_amdgcn_ds_swizzle(__float_as_int(v), 0x401F));
    { auto rr = __builtin_amdgcn_permlane32_swap(__float_as_uint(v), __float_as_uint(v), false, false); v = __uint_as_float(rr[0]) + __uint_as_float(rr[1]); }
    return v;
}
DI unsigned cvtpk(float lo, float hi) { unsigned r; asm volatile("v_cvt_pk_bf16_f32 %0, %1, %2" : "=v"(r) : "v"(lo), "v"(hi)); return r; }
DI float bflo(unsigned w) { return __uint_as_float(w << 16); }
DI float bfhi(unsigned w) { return __uint_as_float(w & 0xffff0000u); }
DI float sigm(float x) { return __builtin_amdgcn_rcpf(1.0f + __builtin_amdgcn_exp2f(-1.4426950408889634f * x)); }
DI float gelu_t(float x) { const float u = x * (1.5957691216057308f + 0.07135481627f * x * x); return x * sigm(u); }
DI bf16* wslot(const Frame& F, int l, size_t off) { return (bf16*)(wsl(F.ws) + WS_W + (size_t)l * W_SLOT + off); }

template <int MAP> DI int srcmap(int nd) { if (MAP == 0) return nd; if (MAP == 2) { const int pn = nd >> 8, r = nd & 255; return r < 128 ? 128 * pn + r : 2048 + 128 * pn + (r - 128); }
    return nd < 3072 ? 936 + nd : (nd - 3072 < 936 ? nd - 3072 : -1); }
template <int MAP> DI void p0_transpose_item(const float* W, int K, int Nsrc, int Ndst, bf16* WT, int ldk, int dst_row_off, LAS float* scr, int item, int lane, int dst_col_off = 0) {
    const int nblk = Ndst / 32, kb = item / nblk, nb = item % nblk, k0 = 64 * kb, n0 = 32 * nb;
    const int ns = srcmap<MAP>(n0 + (lane & 31));
#pragma unroll 8
    for (int i = 0; i < 32; ++i) { const int kk = 2 * i + (lane >> 5); scr[kk * 33 + (lane & 31)] = (ns >= 0) ? W[(size_t)(k0 + kk) * Nsrc + ns] : 0.f; }
    LDS_WAIT(); asm volatile("" ::: "memory");
    const int c = lane & 7;
#pragma unroll
    for (int j = 0; j < 4; ++j) { const int n = (lane >> 3) + 8 * j; const LAS float* s = scr + (8 * c) * 33 + n;
        v4u o; o.x = cvtpk(s[0 * 33], s[1 * 33]); o.y = cvtpk(s[2 * 33], s[3 * 33]); o.z = cvtpk(s[4 * 33], s[5 * 33]); o.w = cvtpk(s[6 * 33], s[7 * 33]);
        *(GAS v4u*)(WT + (size_t)(dst_row_off + n0 + n) * ldk + dst_col_off + k0 + 8 * c) = o; }
    LDS_WAIT(); asm volatile("" ::: "memory");
}
template <int MAP> DI void p0_transpose_item8(const float* W, int K, int Nsrc, int Ndst, unsigned char* WT, int ldk, LAS float* scr, int item, int lane, int dst_col_off = 0, int dst_row_off = 0) {
    const int nblk = Ndst / 32, kb = item / nblk, nb = item % nblk, k0 = 64 * kb, n0 = 32 * nb;
    const int ns = srcmap<MAP>(n0 + (lane & 31));
#pragma unroll 8
    for (int i = 0; i < 32; ++i) { const int kk = 2 * i + (lane >> 5); scr[kk * 33 + (lane & 31)] = (ns >= 0) ? W[(size_t)(k0 + kk) * Nsrc + ns] * W8_SCALE : 0.f; }
    LDS_WAIT(); asm volatile("" ::: "memory");
    const int c = lane & 7;
#pragma unroll
    for (int j = 0; j < 4; ++j) { const int n = (lane >> 3) + 8 * j; const LAS float* s = scr + (8 * c) * 33 + n;
        int p0 = __builtin_amdgcn_cvt_pk_fp8_f32(s[0 * 33], s[1 * 33], 0, false); p0 = __builtin_amdgcn_cvt_pk_fp8_f32(s[2 * 33], s[3 * 33], p0, true);
        int p1 = __builtin_amdgcn_cvt_pk_fp8_f32(s[4 * 33], s[5 * 33], 0, false); p1 = __builtin_amdgcn_cvt_pk_fp8_f32(s[6 * 33], s[7 * 33], p1, true);
        u32x2v o; o.x = (unsigned)p0; o.y = (unsigned)p1;
        *(GAS u32x2v*)(WT + (size_t)(dst_row_off + n0 + n) * ldk + dst_col_off + k0 + 8 * c) = o; }
    LDS_WAIT(); asm volatile("" ::: "memory");
}
DI void p0_prologue(Frame& F, const Args& A) {
    LAS float* scr = (LAS float*)(F.lds + RING_OFF + F.wave * 16384);
    const int gw = F.vcu * NWAVES + F.wave, NGW = F.G * NWAVES, lane = lane_id();
    constexpr int I_IN = (DM / 64) * (4096 / 32), I_UQ = (256 / 64) * (1024 / 32), I_QI = (256 / 64) * (256 / 32), I_PBC = (256 / 64) * (1024 / 32), I_PAI = (512 / 64) * (1024 / 32), I_OUT = (DM / 64) * (DM / 32),
                  I_UPI = (DM / 64) * (4096 / 32), I_DN = (DFF / 64) * (DM / 32), I_GLU = (256 / 64) * (256 / 32);
    constexpr int PER_L = I_IN + I_UQ + I_QI + 2 * I_PBC + I_PAI + I_OUT + I_UPI + I_DN + I_GLU;
    for (int it = gw; it < DEPTH * PER_L; it += NGW) {
        const int l = it / PER_L; int r = it % PER_L;
        if (r < I_IN) { if (IN_FP8 && SMALL_FP8 && (r % (4096 / 32)) >= 3584 / 32) p0_transpose_item8<1>(A.in[I_WIN] + (size_t)l * DM * NIN, DM, NIN, 4096, (unsigned char*)wslot(F, l, W_IN), DM, scr, r, lane, 0, -512);
            else if (IN_FP8 && (r % (4096 / 32)) < 3072 / 32) p0_transpose_item8<1>(A.in[I_WIN] + (size_t)l * DM * NIN, DM, NIN, 4096, (unsigned char*)wslot(F, l, W_IN), DM, scr, r, lane);
            else p0_transpose_item<1>(A.in[I_WIN] + (size_t)l * DM * NIN, DM, NIN, 4096, wslot(F, l, W_IN), DM, 0, scr, r, lane); continue; } r -= I_IN;
        if (r < I_UQ) { p0_transpose_item<0>(A.in[I_WUQ] + (size_t)l * 256 * 1024, 256, 1024, 1024, wslot(F, l, W_Q), 256, 0, scr, r, lane); continue; } r -= I_UQ;
        if (r < I_QI) { p0_transpose_item<0>(A.in[I_WQI] + (size_t)l * 256 * 256, 256, 256, 256, wslot(F, l, W_Q), 256, 1024, scr, r, lane); continue; } r -= I_QI;
        if (r < I_PBC) { if (MERGE_FP8) p0_transpose_item8<0>(A.in[I_PB] + (size_t)l * 256 * 1024, 256, 1024, 1024, (unsigned char*)wslot(F, l, W_M), 1024, scr, r, lane, 512); else p0_transpose_item<0>(A.in[I_PB] + (size_t)l * 256 * 1024, 256, 1024, 1024, wslot(F, l, W_M), 1024, 0, scr, r, lane, 512); continue; } r -= I_PBC;
        if (r < I_PBC) { if (MERGE_FP8) p0_transpose_item8<0>(A.in[I_PC] + (size_t)l * 256 * 1024, 256, 1024, 1024, (unsigned char*)wslot(F, l, W_M), 1024, scr, r, lane, 768); else p0_transpose_item<0>(A.in[I_PC] + (size_t)l * 256 * 1024, 256, 1024, 1024, wslot(F, l, W_M), 1024, 0, scr, r, lane, 768); continue; } r -= I_PBC;
        if (r < I_PAI) { if (MERGE_FP8) p0_transpose_item8<0>(A.in[I_PA] + (size_t)l * 512 * 1024, 512, 1024, 1024, (unsigned char*)wslot(F, l, W_M), 1024, scr, r, lane, 0); else p0_transpose_item<0>(A.in[I_PA] + (size_t)l * 512 * 1024, 512, 1024, 1024, wslot(F, l, W_M), 1024, 0, scr, r, lane, 0); continue; } r -= I_PAI;
        if (r < I_OUT) { if (OUT_FP8) p0_transpose_item8<0>(A.in[I_WOUT] + (size_t)l * DM * DM, DM, DM, DM, (unsigned char*)wslot(F, l, W_OUT), DM, scr, r, lane); else p0_transpose_item<0>(A.in[I_WOUT] + (size_t)l * DM * DM, DM, DM, DM, wslot(F, l, W_OUT), DM, 0, scr, r, lane); continue; } r -= I_OUT;
        if (r < I_UPI) { if (UP_FP8) p0_transpose_item8<2>(A.in[I_WUP] + (size_t)l * DM * 4096, DM, 4096, 4096, (unsigned char*)wslot(F, l, W_UP), DM, scr, r, lane); else p0_transpose_item<2>(A.in[I_WUP] + (size_t)l * DM * 4096, DM, 4096, 4096, wslot(F, l, W_UP), DM, 0, scr, r, lane); continue; } r -= I_UPI;
        if (r < I_DN) { if (DOWN_FP8) p0_transpose_item8<0>(A.in[I_WDOWN] + (size_t)l * DFF * DM, DFF, DM, DM, (unsigned char*)wslot(F, l, W_DOWN), DFF, scr, r, lane); else p0_transpose_item<0>(A.in[I_WDOWN] + (size_t)l * DFF * DM, DFF, DM, DM, wslot(F, l, W_DOWN), DFF, 0, scr, r, lane); continue; } r -= I_DN;
        p0_transpose_item<0>(A.in[I_WGLU] + (size_t)l * 256 * 256, 256, 256, 256, wslot(F, l, W_GLU), 256, 0, scr, r, lane);
    }
    for (int it = gw * 64 + lane; it < DEPTH * 8 * 2 * 4 * 2 * 64; it += NGW * 64) {
        const int ln = it & 63, sx = (it >> 6) & 1, d0 = (it >> 7) & 3, mt = (it >> 9) & 1, lh = it >> 10;
        const int e = 32 * mt + (ln & 31), hi = ln >> 5;
        const float* wv = A.in[I_WUV] + (size_t)lh * 128 * 64 + e;
        float v[8];
#pragma unroll
        for (int j = 0; j < 8; ++j) { const int d = 32 * d0 + 16 * sx + 8 * (j >> 2) + 4 * hi + (j & 3); v[j] = wv[(size_t)d * 64]; }
        v4u o; o.x = cvtpk(v[0], v[1]); o.y = cvtpk(v[2], v[3]); o.z = cvtpk(v[4], v[5]); o.w = cvtpk(v[6], v[7]);
        *(GAS v4u*)(wslot(F, lh >> 3, W_UVF) + ((size_t)((lh & 7) * 16 + mt * 8 + d0 * 2 + sx) * 64 + ln) * 8) = o;
    }
    for (int it = gw * 64 + lane; it < DEPTH * 256 * 256; it += NGW * 64) {
        const int l = it >> 16, n = (it >> 8) & 255, k = it & 255, g = n >> 6, d = n & 63, g2 = k >> 6, c = k & 63;
        const float v = (g == g2) ? A.in[I_WPOOL][(size_t)l * 4 * 64 * 64 + (size_t)(g * 64 + c) * 64 + d] * A.in[I_PSCALE][l * 256 + n] : 0.f;
        wslot(F, l, W_POOL)[(size_t)n * 256 + k] = (bf16)(cvtpk(v, 0.f) & 0xffffu);
    }
    {
        f32x2v* LAMJ = (f32x2v*)(wsl(F.ws) + WS_LAMJ); f32x2v* BBAR = (f32x2v*)(wsl(F.ws) + WS_BBAR);
        for (int it = gw * 64 + lane; it < DEPTH * 16 * 65 * 64; it += NGW * 64) {
            const int n = it & 63, j = (it >> 6) % 65, lg = (it >> 6) / 65;
            const float step = expf(A.in[I_LOGSTEP][lg]), ar = A.in[I_ARE][lg * 64 + n], ai = A.in[I_AIM][lg * 64 + n];
            const float mag = expf(ar * step * (float)j), ang = ai * step * (float)j;
            float sn, cs; sincosf(ang, &sn, &cs);
            LAMJ[it] = (f32x2v){mag * cs, mag * sn};
        }
        for (int it = gw * 64 + lane; it < DEPTH * 16 * 64 * 16; it += NGW * 64) {
            const int q = it & 15, n = (it >> 4) & 63, lg = it >> 10;
            const float step = expf(A.in[I_LOGSTEP][lg]), ar = A.in[I_ARE][lg * 64 + n], ai = A.in[I_AIM][lg * 64 + n];
            const float mag = expf(ar * step); float sn, cs; sincosf(ai * step, &sn, &cs);
            const float nr = mag * cs - 1.f, ni = mag * sn, den = 1.f / (ar * ar + ai * ai);
            const float fr_ = (nr * ar + ni * ai) * den, fi_ = (ni * ar - nr * ai) * den;
            const float br = A.in[I_BRE][(size_t)lg * 1024 + n * 16 + q], bi = A.in[I_BIM][(size_t)lg * 1024 + n * 16 + q];
            BBAR[it] = (f32x2v){fr_ * br - fi_ * bi, fr_ * bi + fi_ * br};
        }
    }
    {
        __syncthreads();
        LAS float* sil = (LAS float*)(F.lds + RING_OFF);
        float* MOD = (float*)(wsl(F.ws) + WS_MOD);
        for (int it = F.vcu; it < DEPTH * (NMOD / 64); it += F.G) {
            const int l = it / (NMOD / 64), n = (it % (NMOD / 64)) * 64 + lane, kw0 = F.wave * 128;
            LAS float* ms = sil + F.wave * 4096;
            for (int e = lane; e < 4096; e += 64) { const int kk = e >> 5, b = e & 31; const float cv = A.in[I_C][b * DM + kw0 + kk]; ms[e] = cv * sigm(cv); }
            LDS_WAIT(); asm volatile("" ::: "memory");
            float acc[32];
#pragma unroll
            for (int b = 0; b < 32; ++b) acc[b] = 0.f;
            const float* wp = A.in[I_MODW] + (size_t)l * DM * NMOD + (size_t)kw0 * NMOD + n;
#pragma unroll 16
            for (int kk = 0; kk < 128; ++kk) { const float w = ((const GAS float*)wp)[(size_t)kk * NMOD];
#pragma unroll
                for (int b = 0; b < 32; ++b) acc[b] += w * ms[kk * 32 + b]; }
            __syncthreads();
            LAS float* red = (LAS float*)(F.lds + RING_OFF);
#pragma unroll
            for (int b = 0; b < 32; ++b) red[(F.wave * 32 + b) * 64 + lane] = acc[b];
            __syncthreads();
            for (int e = F.wave * 64 + lane; e < 32 * 64; e += NWAVES * 64) { const int b = e >> 6, c = e & 63; float s = 0.f;
#pragma unroll
                for (int w = 0; w < 8; ++w) s += red[(w * 32 + b) * 64 + c];
                const int nn = (it % (NMOD / 64)) * 64 + c; MOD[((size_t)l * 32 + b) * NMOD + nn] = s + A.in[I_MODB][l * NMOD + nn]; }
            __syncthreads();
        }
    }
}
DI void p1_kt(Frame& F, const Args& A) {
    const f32x2v* LAMJ = (const f32x2v*)(wsl(F.ws) + WS_LAMJ); const f32x2v* BBAR = (const f32x2v*)(wsl(F.ws) + WS_BBAR); float* KT = (float*)(wsl(F.ws) + WS_KT);
    const int gt = (F.vcu * NWAVES + F.wave) * 64 + lane_id(), NGT = F.G * NWAVES * 64;
    for (int it = gt; it < DEPTH * 16 * 64 * 256; it += NGT) {
        const int q = it & 15, p = (it >> 4) & 15, j = (it >> 8) & 63, lg = it >> 14;
        const float* cre = A.in[I_CRE] + (size_t)lg * 1024 + p * 64; const float* cim = A.in[I_CIM] + (size_t)lg * 1024 + p * 64;
        float a = 0.f;
#pragma unroll 16
        for (int n = 0; n < 64; ++n) { const f32x2v lj = ((const GAS f32x2v*)LAMJ)[((size_t)lg * 65 + j) * 64 + n], bb = ((const GAS f32x2v*)BBAR)[((size_t)lg * 64 + n) * 16 + q];
            const float tr = lj.x * bb.x - lj.y * bb.y, ti = lj.x * bb.y + lj.y * bb.x;
            a += ((const GAS float*)cre)[n] * tr - ((const GAS float*)cim)[n] * ti; }
        if (j == 0 && p == q) a += A.in[I_DSKIP][lg * 16 + p];
        KT[it] = a;
    }
}
DI void s5_expand(Frame& F, const Args& A, int l) {
    const f32x2v* LAMJ = (const f32x2v*)(wsl(F.ws) + WS_LAMJ) + (size_t)l * 16 * 65 * 64; const f32x2v* BBAR = (const f32x2v*)(wsl(F.ws) + WS_BBAR) + (size_t)l * 16 * 64 * 16;
    const float* KT = (const float*)(wsl(F.ws) + WS_KT) + (size_t)l * 16 * 64 * 256;
    bf16* WY = (bf16*)(wsl(F.ws) + WS_WY); bf16* WE = (bf16*)(wsl(F.ws) + WS_WE);
    const int gt = (F.vcu * NWAVES + F.wave) * 64 + lane_id(), NGT = F.G * NWAVES * 64;
#pragma unroll 4
    for (int it = gt; it < 16 * 1024 * 128; it += NGT) {
        const int k8 = it & 127, row = it >> 7, g = row >> 10, t = (row >> 4) & 63, p = row & 15, k = k8 * 8, s = k >> 4, q0 = k & 15;
        const int lag = t - s, lagc = lag < 0 ? 0 : lag;
        const GAS f32x4* kp = (const GAS f32x4*)(KT + ((size_t)(g * 64 + lagc) * 16 + p) * 16 + q0); f32x4 k0 = kp[0], k1 = kp[1];
        if (lag < 0) { k0 = (f32x4){0.f, 0.f, 0.f, 0.f}; k1 = k0; }
        v4u o; o.x = cvtpk(k0.x, k0.y); o.y = cvtpk(k0.z, k0.w); o.z = cvtpk(k1.x, k1.y); o.w = cvtpk(k1.z, k1.w);
        *(GAS v4u*)(WY + (size_t)row * AS5_LD + k) = o;
    }
    for (int it = gt; it < 16 * 1024 * 16; it += NGT) {
        const int k8 = 128 + (it & 15), row = it >> 4, g = row >> 10, t = (row >> 4) & 63, p = row & 15, k = k8 * 8;
        float v[8];
        { const bool im = k >= 1088; const int n0 = (k - 1024) & 63;
            const float* cre = A.in[I_CRE] + (size_t)(l * 16 + g) * 1024 + p * 64 + n0; const float* cim = A.in[I_CIM] + (size_t)(l * 16 + g) * 1024 + p * 64 + n0;
#pragma unroll
            for (int e = 0; e < 8; ++e) { const f32x2v lj = LAMJ[((size_t)g * 65 + (t + 1)) * 64 + n0 + e];
                v[e] = im ? -(cre[e] * lj.y + cim[e] * lj.x) : (cre[e] * lj.x - cim[e] * lj.y); } }
        v4u o; o.x = cvtpk(v[0], v[1]); o.y = cvtpk(v[2], v[3]); o.z = cvtpk(v[4], v[5]); o.w = cvtpk(v[6], v[7]);
        *(GAS v4u*)(WY + (size_t)row * AS5_LD + k) = o;
    }
    for (int it = gt; it < 16 * 256 * 128; it += NGT) {
        const int k8 = it & 127, row = it >> 7, g = row >> 8, r = row & 255, k = k8 * 8, s = k >> 4, q0 = k & 15;
        float v[8];
        if (r < 128) { const int n = r & 63; const f32x2v lj = LAMJ[((size_t)g * 65 + (63 - s)) * 64 + n];
#pragma unroll
            for (int e = 0; e < 8; ++e) { const f32x2v bb = BBAR[((size_t)g * 64 + n) * 16 + q0 + e]; v[e] = (r < 64) ? (lj.x * bb.x - lj.y * bb.y) : (lj.x * bb.y + lj.y * bb.x); } }
        else {
#pragma unroll
            for (int e = 0; e < 8; ++e) v[e] = 0.f; }
        v4u o; o.x = cvtpk(v[0], v[1]); o.y = cvtpk(v[2], v[3]); o.z = cvtpk(v[4], v[5]); o.w = cvtpk(v[6], v[7]);
        *(GAS v4u*)(WE + (size_t)row * 1024 + k) = o;
    }
}

template <int NR, bool HOIST> DI void norm_rows_t(Frame& F, const float* xin, const bf16* Y, const float* gt, const float* gpost, float* xout,
                  const float* gpre, const float* sc, const float* sh, bf16* Hout, const bool permH, const int XB, const int row_base, const int nrows, const int gw, const int NGW) {
    const int lane = lane_id();
    f32x4 T2[4], G2[4], C2[4];
    if (HOIST) { const int b0 = row_base / SEQ;
#pragma unroll
        for (int j = 0; j < 4; ++j) {
            if (Y) T2[j] = *((const GAS f32x4*)(gt + (size_t)b0 * NMOD) + lane + 64 * j) * *((const GAS f32x4*)gpost + lane + 64 * j);
            if (Hout) { G2[j] = *((const GAS f32x4*)gpre + lane + 64 * j) * (*((const GAS f32x4*)(sc + (size_t)b0 * NMOD) + lane + 64 * j) + 1.0f); C2[j] = *((const GAS f32x4*)(sh + (size_t)b0 * NMOD) + lane + 64 * j); } } }
    for (int m0 = gw; m0 < nrows / NR; m0 += NGW) {
        f32x4 xf[NR][4]; u32x2v xp[NR][4]; u32x2v yp[NR][4];
#pragma unroll
        for (int h = 0; h < NR; ++h) { const int m = row_base + m0 + h * (nrows / NR);
            if (XB & 1) { const GAS u32x2v* xr = (const GAS u32x2v*)(xin + (size_t)m * DM) + lane;
#pragma unroll
                for (int j = 0; j < 4; ++j) xp[h][j] = xr[64 * j]; }
            else { const GAS f32x4* xr = (const GAS f32x4*)(xin + (size_t)m * DM) + lane;
#pragma unroll
                for (int j = 0; j < 4; ++j) xf[h][j] = xr[64 * j]; }
            if (Y) { const GAS u32x2v* yr = (const GAS u32x2v*)(Y + (size_t)m * DM) + lane;
#pragma unroll
                for (int j = 0; j < 4; ++j) yp[h][j] = yr[64 * j]; } }
#pragma unroll
        for (int h = 0; h < NR; ++h) { const int m = row_base + m0 + h * (nrows / NR), b = m / SEQ;
            f32x4 x[4];
#pragma unroll
            for (int j = 0; j < 4; ++j) x[j] = (XB & 1) ? (f32x4){bflo(xp[h][j].x), bfhi(xp[h][j].x), bflo(xp[h][j].y), bfhi(xp[h][j].y)} : xf[h][j];
            if (Y) {
                f32x4 y[4]; float s = 0.f;
#pragma unroll
                for (int j = 0; j < 4; ++j) { y[j] = (f32x4){bflo(yp[h][j].x), bfhi(yp[h][j].x), bflo(yp[h][j].y), bfhi(yp[h][j].y)}; s += (y[j].x * y[j].x + y[j].y * y[j].y) + (y[j].z * y[j].z + y[j].w * y[j].w); }
                const float r = 1.0f / sqrtf(wave_sum(s, lane) * (1.f / DM) + RMS_EPS);
#pragma unroll
                for (int j = 0; j < 4; ++j) { if (HOIST) x[j] = x[j] + T2[j] * (y[j] * r);
                    else { const f32x4 g = *((const GAS f32x4*)gpost + lane + 64 * j), t = *((const GAS f32x4*)(gt + (size_t)b * NMOD) + lane + 64 * j);
                    x[j] = x[j] + t * (y[j] * r * g); } }
                if (XB & 2) { GAS u32x2v* xo = (GAS u32x2v*)(xout + (size_t)m * DM) + lane;
#pragma unroll
                    for (int j = 0; j < 4; ++j) { u32x2v w; w.x = cvtpk(x[j].x, x[j].y); w.y = cvtpk(x[j].z, x[j].w); xo[64 * j] = w;
                        x[j] = (f32x4){bflo(w.x), bfhi(w.x), bflo(w.y), bfhi(w.y)}; } }
                else { GAS f32x4* xo = (GAS f32x4*)(xout + (size_t)m * DM) + lane;
#pragma unroll
                    for (int j = 0; j < 4; ++j) xo[64 * j] = x[j]; }
            }
            if (Hout) {
                float q = 0.f;
#pragma unroll
                for (int j = 0; j < 4; ++j) q += (x[j].x * x[j].x + x[j].y * x[j].y) + (x[j].z * x[j].z + x[j].w * x[j].w);
                const float r = 1.0f / sqrtf(wave_sum(q, lane) * (1.f / DM) + RMS_EPS);
                const int tt = m & 255, hrow = permH ? (m & ~255) + 128 * ((tt >> 2) & 1) + 64 * (tt >> 7) + 16 * (tt & 3) + ((tt >> 3) & 15) : m;
                GAS u32x2v* ho = (GAS u32x2v*)(Hout + (size_t)hrow * DM) + lane;
#pragma unroll
                for (int j = 0; j < 4; ++j) { f32x4 hv;
                    if (HOIST) hv = x[j] * r * G2[j] + C2[j];
                    else { const f32x4 g = *((const GAS f32x4*)gpre + lane + 64 * j), a = *((const GAS f32x4*)(sc + (size_t)b * NMOD) + lane + 64 * j), c = *((const GAS f32x4*)(sh + (size_t)b * NMOD) + lane + 64 * j);
                    hv = x[j] * r * g * (a + 1.0f) + c; }
                    if (UP_FP8 && permH) { int p8 = __builtin_amdgcn_cvt_pk_fp8_f32(pg8::sat8(hv.x), pg8::sat8(hv.y), 0, false); p8 = __builtin_amdgcn_cvt_pk_fp8_f32(pg8::sat8(hv.z), pg8::sat8(hv.w), p8, true); ((GAS unsigned*)((GAS unsigned char*)Hout + (size_t)hrow * DM))[lane + 64 * j] = (unsigned)p8; }
                    else { u32x2v w; w.x = cvtpk(hv.x, hv.y); w.y = cvtpk(hv.z, hv.w); ho[64 * j] = w;
                        if (IN_FP8 && !permH) { int p8 = __builtin_amdgcn_cvt_pk_fp8_f32(pg8::sat8(hv.x), pg8::sat8(hv.y), 0, false); p8 = __builtin_amdgcn_cvt_pk_fp8_f32(pg8::sat8(hv.z), pg8::sat8(hv.w), p8, true); ((GAS unsigned*)((GAS unsigned char*)(wsl(F.ws) + WS_H8) + (size_t)hrow * DM))[lane + 64 * j] = (unsigned)p8; } } }
            }
        }
    }
}
DI void norm_rows(Frame& F, const float* xin, const bf16* Y, const float* gt, const float* gpost, float* xout,
                  const float* gpre, const float* sc, const float* sh, bf16* Hout, const bool permH = false, const int XB = 0) {
    const int gw = F.vcu * NWAVES + F.wave, NGW = F.G * NWAVES;
    if (XB & 1) norm_rows_t<8, false>(F, xin, Y, gt, gpost, xout, gpre, sc, sh, Hout, permH, XB, 0, MTOK, gw, NGW);
    else norm_rows_t<4, false>(F, xin, Y, gt, gpost, xout, gpre, sc, sh, Hout, permH, XB, 0, MTOK, gw, NGW);
}
DI void norm_panel(Frame& F, int pm, const float* xin, const bf16* Y, const float* gt, const float* gpost, float* xout,
                   const float* gpre, const float* sc, const float* sh, bf16* Hout, const bool permH, const int XB) {
    if (XB & 1) norm_rows_t<8, true>(F, xin, Y, gt, gpost, xout, gpre, sc, sh, Hout, permH, XB, pm * 256, 256, F.wave, NWAVES);
    else norm_rows_t<4, true>(F, xin, Y, gt, gpost, xout, gpre, sc, sh, Hout, permH, XB, pm * 256, 256, F.wave, NWAVES);
}
DI void panel_sync() {
    asm volatile("s_waitcnt vmcnt(0)" ::: "memory"); __syncthreads();
    asm volatile("buffer_inv sc0\n\ts_waitcnt vmcnt(0)" ::: "memory"); __syncthreads();
}
template <int r> DI void small_ops_row(Frame& F, const v4u (&w0)[4], const v4u (&w1)[4], const v4u (&wv)[15], float (&sm)[8], const int m0, const int b, const int t0, const int lane,
                                    const bool plane, const int pp, const int grp, const int win, bf16* CQN, bf16* CKVN, bf16* KI, float* WI, bf16* AS5, bf16* PO, const float* gcq, const float* gckv) {
    const int m = m0 + r, t = t0 + r;
            { const v4u w0r = w0[r];
    float a[8] = {bflo(w0r.x), bfhi(w0r.x), bflo(w0r.y), bfhi(w0r.y), bflo(w0r.z), bfhi(w0r.z), bflo(w0r.w), bfhi(w0r.w)};
    float ss = 0.f;
#pragma unroll
    for (int e = 0; e < 8; ++e) ss += a[e] * a[e];
    const float s_cq = wave_sum(lane < 32 ? ss : 0.f, lane), s_kv = wave_sum((lane >= 32 && lane < 48) ? ss : 0.f, lane);
    const float r_cq = 1.0f / sqrtf(s_cq * (1.f / 256.f) + RMS_EPS), r_kv = 1.0f / sqrtf(s_kv * (1.f / 128.f) + RMS_EPS);
    if (lane < 32) { const f32x4 g0 = *(const GAS f32x4*)(gcq + 8 * lane), g1 = *(const GAS f32x4*)(gcq + 8 * lane + 4);
        v4u o; o.x = cvtpk(a[0] * r_cq * g0.x, a[1] * r_cq * g0.y); o.y = cvtpk(a[2] * r_cq * g0.z, a[3] * r_cq * g0.w); o.z = cvtpk(a[4] * r_cq * g1.x, a[5] * r_cq * g1.y); o.w = cvtpk(a[6] * r_cq * g1.z, a[7] * r_cq * g1.w);
        *(GAS v4u*)(CQN + (size_t)m * 256 + 8 * lane) = o; }
    else if (lane < 48) { const int c = 8 * (lane - 32); const f32x4 g0 = *(const GAS f32x4*)(gckv + c), g1 = *(const GAS f32x4*)(gckv + c + 4);
        v4u o; o.x = cvtpk(a[0] * r_kv * g0.x, a[1] * r_kv * g0.y); o.y = cvtpk(a[2] * r_kv * g0.z, a[3] * r_kv * g0.w); o.z = cvtpk(a[4] * r_kv * g1.x, a[5] * r_kv * g1.y); o.w = cvtpk(a[6] * r_kv * g1.z, a[7] * r_kv * g1.w);
        *(GAS v4u*)(CKVN + (size_t)m * 128 + c) = o; }
    else if (lane < 52) { *(GAS v4u*)(KI + (size_t)m * 32 + 8 * (lane - 48)) = w0r; }
    else if (lane == 52) { *(GAS f32x4*)(WI + (size_t)m * 8) = (f32x4){a[0], a[1], a[2], a[3]}; *(GAS f32x4*)(WI + (size_t)m * 8 + 4) = (f32x4){a[4], a[5], a[6], a[7]}; } }
    const int kc = t >> 6, s = t & 63;
    if (lane >= 53) { const int p = lane - 53, g = p >> 1, q0 = 8 * (p & 1);
        *(GAS v4u*)(AS5 + (size_t)(g * 1024 + b * 32 + kc) * AS5_LD + s * 16 + q0) = w0[r]; }
    if (lane <= 20) { const int p = lane + 11, g = p >> 1, q0 = 8 * (p & 1);
        *(GAS v4u*)(AS5 + (size_t)(g * 1024 + b * 32 + kc) * AS5_LD + s * 16 + q0) = w1[r]; }
    if (plane) {
        const v4u w1r = w1[r];
        const float u[8] = {bflo(w1r.x), bfhi(w1r.x), bflo(w1r.y), bfhi(w1r.y), bflo(w1r.z), bfhi(w1r.z), bflo(w1r.w), bfhi(w1r.w)};
        if constexpr (r == 0) {
#pragma unroll
            for (int e = 0; e < 8; ++e) sm[e] = u[e];
#pragma unroll
            for (int i = 0; i < 15; ++i) { sm[0] += bflo(wv[i].x); sm[1] += bfhi(wv[i].x); sm[2] += bflo(wv[i].y); sm[3] += bfhi(wv[i].y); sm[4] += bflo(wv[i].z); sm[5] += bfhi(wv[i].z); sm[6] += bflo(wv[i].w); sm[7] += bfhi(wv[i].w); }
        } else {
            const unsigned k3 = grp == 3 ? ~0u : 0u, k2 = grp == 2 ? ~0u : 0u, k1 = grp == 1 ? ~0u : 0u, k0 = grp == 0 ? ~0u : 0u;
            const v4u c3 = wv[15 - r], c2 = wv[7 - r], c1 = wv[3 - r], c0 = (r == 1) ? wv[0] : w1[r - 2 < 0 ? 0 : r - 2];
            v4u lv; lv.x = (c3.x & k3) | (c2.x & k2) | (c1.x & k1) | (c0.x & k0); lv.y = (c3.y & k3) | (c2.y & k2) | (c1.y & k1) | (c0.y & k0);
            lv.z = (c3.z & k3) | (c2.z & k2) | (c1.z & k1) | (c0.z & k0); lv.w = (c3.w & k3) | (c2.w & k2) | (c1.w & k1) | (c0.w & k0);
#pragma unroll
            for (int e = 0; e < 8; ++e) sm[e] += u[e];
            sm[0] -= bflo(lv.x); sm[1] -= bfhi(lv.x); sm[2] -= bflo(lv.y); sm[3] -= bfhi(lv.y); sm[4] -= bflo(lv.z); sm[5] -= bfhi(lv.z); sm[6] -= bflo(lv.w); sm[7] -= bfhi(lv.w);
        }
        const int cnt = (t + 1 < win) ? (t + 1) : win; const float ic = 1.0f / (float)cnt;
        v4u o; o.x = cvtpk(sm[0] * ic - u[0], sm[1] * ic - u[1]); o.y = cvtpk(sm[2] * ic - u[2], sm[3] * ic - u[3]); o.z = cvtpk(sm[4] * ic - u[4], sm[5] * ic - u[5]); o.w = cvtpk(sm[6] * ic - u[6], sm[7] * ic - u[7]);
        *(GAS v4u*)(PO + (size_t)m * 256 + 8 * pp) = o;
    }
}
DI void small_ops(Frame& F, const Args& A, int l) {
    const int gw = F.vcu * NWAVES + F.wave, NGW = F.G * NWAVES, lane = lane_id();
    const bf16* ZS = (const bf16*)(wsl(F.ws) + WS_ZS);
    bf16* CQN = (bf16*)(wsl(F.ws) + WS_CQN); bf16* CKVN = (bf16*)(wsl(F.ws) + WS_CKVN); bf16* KI = (bf16*)(wsl(F.ws) + WS_KI); float* WI = (float*)(wsl(F.ws) + WS_WI);
    bf16* AS5 = (bf16*)(wsl(F.ws) + WS_AS5); bf16* PO = (bf16*)(wsl(F.ws) + WS_POOLED);
    const float* gcq = A.in[I_GCQ] + l * 256; const float* gckv = A.in[I_GCKV] + l * 128;
#pragma nounroll
    for (int mg = gw; mg < MTOK / 4; mg += NGW) {
        const int m0 = mg * 4, b = m0 / SEQ, t0 = m0 % SEQ;
        const bf16* zr0 = ZS + (size_t)m0 * 1024;
        v4u w0[4], w1[4];
#pragma unroll
        for (int r = 0; r < 4; ++r) { w0[r] = *(const GAS v4u*)(zr0 + (size_t)r * 1024 + 8 * lane); w1[r] = *(const GAS v4u*)(zr0 + (size_t)r * 1024 + 512 + 8 * lane); }
        const bool plane = lane >= 21 && lane <= 52; const int pp = lane - 21, grp = (pp >> 3) & 3, win = 2 << grp;
        v4u wv[15];
#define SO_LW(i) { wv[(i) - 1] = (v4u){0u, 0u, 0u, 0u}; if (plane && (i) < win && (i) <= t0) wv[(i) - 1] = *(const GAS v4u*)(zr0 - (size_t)(i) * 1024 + 512 + 8 * lane); }
        SO_LW(1) SO_LW(2) SO_LW(3) SO_LW(4) SO_LW(5) SO_LW(6) SO_LW(7) SO_LW(8) SO_LW(9) SO_LW(10) SO_LW(11) SO_LW(12) SO_LW(13) SO_LW(14) SO_LW(15)
#undef SO_LW
        float sm[8];
        small_ops_row<0>(F, w0, w1, wv, sm, m0, b, t0, lane, plane, pp, grp, win, CQN, CKVN, KI, WI, AS5, PO, gcq, gckv);
        small_ops_row<1>(F, w0, w1, wv, sm, m0, b, t0, lane, plane, pp, grp, win, CQN, CKVN, KI, WI, AS5, PO, gcq, gckv);
        small_ops_row<2>(F, w0, w1, wv, sm, m0, b, t0, lane, plane, pp, grp, win, CQN, CKVN, KI, WI, AS5, PO, gcq, gckv);
        small_ops_row<3>(F, w0, w1, wv, sm, m0, b, t0, lane, plane, pp, grp, win, CQN, CKVN, KI, WI, AS5, PO, gcq, gckv);
    }
}
DI void s5_scan(Frame& F, int l) {
    const int gw = F.wave * F.G + F.vcu, NGW = F.G * NWAVES, n = lane_id();
    const f32x2v* LAMJ = (const f32x2v*)(wsl(F.ws) + WS_LAMJ) + (size_t)l * 16 * 65 * 64; const float* E = (const float*)(wsl(F.ws) + WS_E); bf16* AS5 = (bf16*)(wsl(F.ws) + WS_AS5);
    for (int it = gw; it < 16 * BATCH; it += NGW) {
        const int g = it >> 5, b = it & 31; const f32x2v lam = LAMJ[((size_t)g * 65 + 64) * 64 + n];
        float sr = 0.f, si = 0.f; const size_t row0 = (size_t)g * 1024 + b * 32;
        float er[32], ei[32];
#pragma unroll
        for (int k = 0; k < 32; ++k) { er[k] = ((const GAS float*)E)[(row0 + k) * 128 + n]; ei[k] = ((const GAS float*)E)[(row0 + k) * 128 + 64 + n]; }
#pragma unroll
        for (int k = 0; k < 32; ++k) {
            GAS bf16* ar = (GAS bf16*)(AS5 + (row0 + k) * AS5_LD + 1024);
            ar[n] = (bf16)(cvtpk(sr, 0.f) & 0xffffu); ar[64 + n] = (bf16)(cvtpk(si, 0.f) & 0xffffu);
            const float nr = lam.x * sr - lam.y * si + er[k], ni = lam.x * si + lam.y * sr + ei[k]; sr = nr; si = ni;
        }
    }
}
DI void conv_fixup(Frame& F, const Args& A, int l, const int pm) {
    const int gt = pm * 512 + F.wave * 64 + lane_id(), NGT = 1 << 30;
    const float* HALO = (const float*)(wsl(F.ws) + WS_HALO); bf16* A2 = (bf16*)(wsl(F.ws) + WS_A2);
    const float* cw = A.in[I_CONVW] + (size_t)l * 3 * 4096; const float* cb = A.in[I_CONVB] + (size_t)l * 4096;
    { const int it = gt;
        const int R = it >> 8, j0 = (it & 255) * 8, t0 = R * 128; const bool first = (t0 % SEQ) == 0;
        float f0[8], f1[8];
#pragma unroll
        for (int h = 0; h < 2; ++h) {
            const int j = j0 + 4 * h;
            f32x4 r0[2], r1[2];
#pragma unroll
            for (int gv = 0; gv < 2; ++gv) { const int c = gv * 2048 + j;
                const f32x4 w0 = *(const GAS f32x4*)(cw + c), w1 = *(const GAS f32x4*)(cw + 4096 + c), w2 = *(const GAS f32x4*)(cw + 8192 + c), bb = *(const GAS f32x4*)(cb + c);
                const f32x4 z = {0.f, 0.f, 0.f, 0.f};
                const f32x4 p2 = first ? z : *(const GAS f32x4*)(HALO + ((size_t)(R - 1) * 4 + 2) * 4096 + c), p3 = first ? z : *(const GAS f32x4*)(HALO + ((size_t)(R - 1) * 4 + 3) * 4096 + c);
                const f32x4 q0 = *(const GAS f32x4*)(HALO + ((size_t)R * 4 + 0) * 4096 + c), q1 = *(const GAS f32x4*)(HALO + ((size_t)R * 4 + 1) * 4096 + c);
                if (UP_FP8) { const float usc = 1.0f / W8_SCALE; r0[gv] = bb + (w0 * p2 + w1 * p3 + w2 * q0) * usc; r1[gv] = bb + (w0 * p3 + w1 * q0 + w2 * q1) * usc; }
                else { r0[gv] = bb + w0 * p2 + w1 * p3 + w2 * q0; r1[gv] = bb + w0 * p3 + w1 * q0 + w2 * q1; } }
            f0[4 * h] = gelu_t(r0[0].x) * r0[1].x; f0[4 * h + 1] = gelu_t(r0[0].y) * r0[1].y; f0[4 * h + 2] = gelu_t(r0[0].z) * r0[1].z; f0[4 * h + 3] = gelu_t(r0[0].w) * r0[1].w;
            f1[4 * h] = gelu_t(r1[0].x) * r1[1].x; f1[4 * h + 1] = gelu_t(r1[0].y) * r1[1].y; f1[4 * h + 2] = gelu_t(r1[0].z) * r1[1].z; f1[4 * h + 3] = gelu_t(r1[0].w) * r1[1].w;
            if (DOWN_FP8) {
#pragma unroll
                for (int q = 0; q < 4; ++q) { f0[4 * h + q] = pg8::sat8(f0[4 * h + q]); f1[4 * h + q] = pg8::sat8(f1[4 * h + q]); } }
        }
        if (DOWN_FP8) { GAS unsigned char* A8 = (GAS unsigned char*)A2; u32x2v w0_, w1_;
            int p = __builtin_amdgcn_cvt_pk_fp8_f32(f0[0], f0[1], 0, false); p = __builtin_amdgcn_cvt_pk_fp8_f32(f0[2], f0[3], p, true); w0_.x = (unsigned)p; p = __builtin_amdgcn_cvt_pk_fp8_f32(f0[4], f0[5], 0, false); p = __builtin_amdgcn_cvt_pk_fp8_f32(f0[6], f0[7], p, true); w0_.y = (unsigned)p;
            p = __builtin_amdgcn_cvt_pk_fp8_f32(f1[0], f1[1], 0, false); p = __builtin_amdgcn_cvt_pk_fp8_f32(f1[2], f1[3], p, true); w1_.x = (unsigned)p; p = __builtin_amdgcn_cvt_pk_fp8_f32(f1[4], f1[5], 0, false); p = __builtin_amdgcn_cvt_pk_fp8_f32(f1[6], f1[7], p, true); w1_.y = (unsigned)p;
            *(GAS u32x2v*)(A8 + (size_t)t0 * 2048 + j0) = w0_; *(GAS u32x2v*)(A8 + (size_t)(t0 + 1) * 2048 + j0) = w1_; }
        else {
        *(GAS v4u*)(A2 + (size_t)t0 * 2048 + j0) = (v4u){cvtpk(f0[0], f0[1]), cvtpk(f0[2], f0[3]), cvtpk(f0[4], f0[5]), cvtpk(f0[6], f0[7])};
        *(GAS v4u*)(A2 + (size_t)(t0 + 1) * 2048 + j0) = (v4u){cvtpk(f1[0], f1[1]), cvtpk(f1[2], f1[3]), cvtpk(f1[4], f1[5]), cvtpk(f1[6], f1[7])}; }
    }
}
DI void conv_gate(Frame& F, const Args& A, int l) {
    const int gw = F.vcu * NWAVES + F.wave, NGW = F.G * NWAVES, lane = lane_id();
    const bf16* U = (const bf16*)(wsl(F.ws) + WS_U); bf16* A2 = (bf16*)(wsl(F.ws) + WS_A2);
    const float* cw = A.in[I_CONVW] + (size_t)l * 3 * 4096; const float* cb = A.in[I_CONVB] + (size_t)l * 4096;
    for (int it = gw; it < (MTOK / 64) * 4; it += NGW) {
        const int cbk = it & 3, run = it >> 2, j0 = cbk * 512 + lane * 8, t0 = run * 64;
        float wg[3][8], wv[3][8], bg[8], bv[8];
#pragma unroll
        for (int k = 0; k < 3; ++k)
#pragma unroll
            for (int e = 0; e < 8; ++e) { wg[k][e] = cw[k * 4096 + j0 + e]; wv[k][e] = cw[k * 4096 + 2048 + j0 + e]; }
#pragma unroll
        for (int e = 0; e < 8; ++e) { bg[e] = cb[j0 + e]; bv[e] = cb[2048 + j0 + e]; }
        v4u g1 = {0, 0, 0, 0}, g2 = {0, 0, 0, 0}, v1 = {0, 0, 0, 0}, v2 = {0, 0, 0, 0};
        if ((t0 % SEQ) != 0) { const bf16* p1 = U + (size_t)(t0 - 1) * 4096 + j0; const bf16* p2 = U + (size_t)(t0 - 2) * 4096 + j0;
            g1 = *(const GAS v4u*)p1; v1 = *(const GAS v4u*)(p1 + 2048); g2 = *(const GAS v4u*)p2; v2 = *(const GAS v4u*)(p2 + 2048); }
        v4u gn = *(const GAS v4u*)(U + (size_t)t0 * 4096 + j0), vn = *(const GAS v4u*)(U + (size_t)t0 * 4096 + j0 + 2048), gn2, vn2;
        gn2 = *(const GAS v4u*)(U + (size_t)(t0 + 1) * 4096 + j0); vn2 = *(const GAS v4u*)(U + (size_t)(t0 + 1) * 4096 + j0 + 2048);
        for (int r = 0; r < 64; ++r) {
            const v4u g0 = gn, v0 = vn; gn = gn2; vn = vn2;
            if (r + 2 < 64) { const bf16* p2 = U + (size_t)(t0 + r + 2) * 4096 + j0; gn2 = *(const GAS v4u*)p2; vn2 = *(const GAS v4u*)(p2 + 2048); }
            const unsigned G0[4] = {g0.x, g0.y, g0.z, g0.w}, G1[4] = {g1.x, g1.y, g1.z, g1.w}, G2[4] = {g2.x, g2.y, g2.z, g2.w};
            const unsigned V0[4] = {v0.x, v0.y, v0.z, v0.w}, V1[4] = {v1.x, v1.y, v1.z, v1.w}, V2[4] = {v2.x, v2.y, v2.z, v2.w};
            unsigned o[4];
#pragma unroll
            for (int h = 0; h < 4; ++h) {
                const float ga = bg[2 * h] + wg[0][2 * h] * bflo(G2[h]) + wg[1][2 * h] * bflo(G1[h]) + wg[2][2 * h] * bflo(G0[h]);
                const float gb = bg[2 * h + 1] + wg[0][2 * h + 1] * bfhi(G2[h]) + wg[1][2 * h + 1] * bfhi(G1[h]) + wg[2][2 * h + 1] * bfhi(G0[h]);
                const float va = bv[2 * h] + wv[0][2 * h] * bflo(V2[h]) + wv[1][2 * h] * bflo(V1[h]) + wv[2][2 * h] * bflo(V0[h]);
                const float vb = bv[2 * h + 1] + wv[0][2 * h + 1] * bfhi(V2[h]) + wv[1][2 * h + 1] * bfhi(V1[h]) + wv[2][2 * h + 1] * bfhi(V0[h]);
                o[h] = cvtpk(gelu_t(ga) * va, gelu_t(gb) * vb);
            }
            *(GAS v4u*)(A2 + (size_t)(t0 + r) * 2048 + j0) = (v4u){o[0], o[1], o[2], o[3]};
            g2 = g1; v2 = v1; g1 = g0; v1 = v0;
        }
    }
}

using f32x16 = __attribute__((ext_vector_type(16))) float;
#define SBAR() __builtin_amdgcn_sched_barrier(0)
using s16x4 = __attribute__((ext_vector_type(4))) short;
DI void dsa_unit(int i2, int e, int& b, int& qb) { b = i2 >> 3; const int kk = i2 & 7; qb = (e >> 1) * 16 + ((e & 1) ? 15 - kk : kk); }
DI unsigned swap32(unsigned v) { auto rr = __builtin_amdgcn_permlane32_swap(v, v, false, false); return rr[0] ^ rr[1] ^ v; }

#ifndef REP_ISC
#define REP_ISC 1
#endif
#ifndef REP_IBI
#define REP_IBI 1
#endif
#define IDXREP(n) _Pragma("nounroll") for (int _r = 0; _r < (n); ++_r)
#define RELU(x) __int_as_float(max(__float_as_int(x), 0))
DI void indexer_wave(Frame& F, int b, int q4) {
    const int lane = lane_id(), kl = lane & 31, hi = lane >> 5;
    const bf16* QQ = (const bf16*)(wsl(F.ws) + WS_QQ); const float* WI = (const float*)(wsl(F.ws) + WS_WI); unsigned* SELQ = (unsigned*)(wsl(F.ws) + WS_SELQ);
    const int s0 = q4 * 4, c = s0 >> 6, nkeys = 64 * (c + 1), ntile = nkeys >> 5, NT = c + 1, ntile_eff = 2 * (NT + (NT & 1));
    const size_t qrow = (size_t)b * SEQ + s0;
    const bf16* qp = QQ + (qrow + (kl >> 3)) * 1280 + 1024 + (kl & 7) * 32 + 8 * hi;
    const bf16x8 qa0 = *(const GAS bf16x8*)qp, qa1 = *(const GAS bf16x8*)(qp + 16);
    f32x2v w2[8];
#pragma unroll
    for (int qq = 0; qq < 4; ++qq) { const f32x4 wv = *(const GAS f32x4*)(WI + (qrow + qq) * 8 + 4 * hi); w2[2 * qq] = (f32x2v){wv.x, wv.y}; w2[2 * qq + 1] = (f32x2v){wv.z, wv.w}; }
    f32x2v sc[64];
    const LAS unsigned char* kimg = F.lds + RING_OFF;
    const int ksw = (kl >> 2) & 3;
    int zs = 0; asm volatile("" : "+s"(zs));
    const float NINF = __uint_as_float(0xff800000u | (unsigned)zs);
#define IDX_TILE_MFMA(T, CC) { const LAS unsigned char* kp = kimg + ((T) * 32 + kl) * 64; \
        const bf16x8 kb0 = *(const LAS bf16x8*)(kp + ((hi ^ ksw) << 4)), kb1 = *(const LAS bf16x8*)(kp + (((2 + hi) ^ ksw) << 4)); \
        CC = (f32x16){0.f, 0.f, 0.f, 0.f, 0.f, 0.f, 0.f, 0.f, 0.f, 0.f, 0.f, 0.f, 0.f, 0.f, 0.f, 0.f}; \
        CC = __builtin_amdgcn_mfma_f32_32x32x16_bf16(qa0, kb0, CC, 0, 0, 0); CC = __builtin_amdgcn_mfma_f32_32x32x16_bf16(qa1, kb1, CC, 0, 0, 0); }
#define IDX_TILE_VALU(T, CC) { float sq[4]; \
        _Pragma("unroll") for (int qq = 0; qq < 4; ++qq) { f32x2v p = (f32x2v){RELU(CC[4 * qq]), RELU(CC[4 * qq + 1])} * w2[2 * qq]; p = (f32x2v){RELU(CC[4 * qq + 2]), RELU(CC[4 * qq + 3])} * w2[2 * qq + 1] + p; sq[qq] = p.x + p.y; } \
        const auto r0 = __builtin_amdgcn_permlane32_swap(__float_as_uint(sq[0]), __float_as_uint(sq[2]), false, false); \
        const auto r1 = __builtin_amdgcn_permlane32_swap(__float_as_uint(sq[1]), __float_as_uint(sq[3]), false, false); \
        sc[T].x = __uint_as_float(r0[0]) + __uint_as_float(r0[1]); sc[T].y = __uint_as_float(r1[0]) + __uint_as_float(r1[1]); }
    IDXREP(REP_ISC)
#pragma unroll
    for (int t = 0; t < 64; t += 2) {
        if (t < ntile) {
            f32x16 ccA, ccB;
            IDX_TILE_MFMA(t, ccA); IDX_TILE_MFMA(t + 1, ccB);
            IDX_TILE_VALU(t, ccA); IDX_TILE_VALU(t + 1, ccB);
            asm volatile("" : "+v"(sc[t]), "+v"(sc[t + 1]));
        } else { sc[t].x = NINF; sc[t].y = NINF; sc[t + 1].x = NINF; sc[t + 1].y = NINF; }
    }
#undef IDX_TILE_MFMA
#undef IDX_TILE_VALU
    f32x2v T = {NINF, NINF};
    const float tvn = __uint_as_float(0x7fc00000u | (unsigned)zs);
    f32x2v tv = {tvn, tvn};
    unsigned need0 = 0u, need1 = 0u;
    IDXREP(REP_IBI) {
    if (nkeys > 256) {
        unsigned am0 = 0u, am1 = 0u;
#pragma unroll
        for (int t = 0; t < 64; ++t) if (t < ntile) { am0 = max(am0, __float_as_uint(sc[t].x) & 0x7fffffffu); am1 = max(am1, __float_as_uint(sc[t].y) & 0x7fffffffu); }
#pragma unroll
        for (int o = 1; o < 32; o <<= 1) { am0 = max(am0, (unsigned)__builtin_amdgcn_ds_bpermute((lane ^ o) << 2, (int)am0)); am1 = max(am1, (unsigned)__builtin_amdgcn_ds_bpermute((lane ^ o) << 2, (int)am1)); }
        f32x2v hi2 = {__uint_as_float(am0), __uint_as_float(am1)};
        f32x2v lo2 = {-1.001f * hi2.x - 1e-30f, -1.001f * hi2.y - 1e-30f};
        bool d0 = false, d1 = false; unsigned ch0 = 0u, ch1 = 0u;
        const f32x2v big2 = {1.2676506002282294e30f, 1.2676506002282294e30f};
#pragma nounroll
        for (int it = 0; it < 64; ++it) {
            if (__all(d0 && d1)) break;
            const f32x2v mid = (lo2 + hi2) * 0.5f;
            const f32x2v c2 = mid * (-1.2676506002282294e30f);
            f32x2v cA = {0.f, 0.f}, cB = {0.f, 0.f}, cC = {0.f, 0.f}, cD = {0.f, 0.f};
#pragma unroll
            for (int t8 = 0; t8 < 8; ++t8) {
                if (t8 * 8 < ntile) {
#pragma unroll
                    for (int tt = 0; tt < 8; tt += 4) { f32x2v i0, i1, i2, i3;
                        asm("v_pk_fma_f32 %0, %1, %2, %3 clamp" : "=v"(i0) : "v"(sc[t8 * 8 + tt]), "v"(big2), "v"(c2)); asm("v_pk_fma_f32 %0, %1, %2, %3 clamp" : "=v"(i1) : "v"(sc[t8 * 8 + tt + 1]), "v"(big2), "v"(c2));
                        asm("v_pk_fma_f32 %0, %1, %2, %3 clamp" : "=v"(i2) : "v"(sc[t8 * 8 + tt + 2]), "v"(big2), "v"(c2)); asm("v_pk_fma_f32 %0, %1, %2, %3 clamp" : "=v"(i3) : "v"(sc[t8 * 8 + tt + 3]), "v"(big2), "v"(c2));
                        cA += i0; cB += i1; cC += i2; cD += i3; } }
            }
            const f32x2v cnt = (cA + cB) + (cC + cD);
            unsigned pk = (unsigned)(int)(cnt.x + 0.5f) | ((unsigned)(int)(cnt.y + 0.5f) << 16);
            pk += (unsigned)__builtin_amdgcn_update_dpp(0, (int)pk, 0xB1, 0xf, 0xf, true);
            pk += (unsigned)__builtin_amdgcn_update_dpp(0, (int)pk, 0x4E, 0xf, 0xf, true);
            pk += (unsigned)__builtin_amdgcn_update_dpp(0, (int)pk, 0x141, 0xf, 0xf, true);
            pk += (unsigned)__builtin_amdgcn_update_dpp(0, (int)pk, 0x140, 0xf, 0xf, true);
            pk += (unsigned)__builtin_amdgcn_ds_swizzle((int)pk, 0x401F);
            const unsigned n0 = pk & 0xffffu, n1 = pk >> 16;
            if (!d0) { if (!(mid.x > lo2.x && mid.x < hi2.x)) { T.x = hi2.x; tv.x = hi2.x; need0 = 256u - ch0; d0 = true; }
                       else if (n0 > 256u) lo2.x = mid.x; else if (n0 < 256u) { hi2.x = mid.x; ch0 = n0; } else { T.x = mid.x; d0 = true; } }
            if (!d1) { if (!(mid.y > lo2.y && mid.y < hi2.y)) { T.y = hi2.y; tv.y = hi2.y; need1 = 256u - ch1; d1 = true; }
                       else if (n1 > 256u) lo2.y = mid.y; else if (n1 < 256u) { hi2.y = mid.y; ch1 = n1; } else { T.y = mid.y; d1 = true; } }
        }
        if (!d0) { T.x = hi2.x; tv.x = hi2.x; need0 = 256u - ch0; }
        if (!d1) { T.y = hi2.y; tv.y = hi2.y; need1 = 256u - ch1; }
    }
    }
    const bool anytie = __any(need0 != 0u || need1 != 0u);
    if (!anytie) {
#pragma unroll
        for (int t = 0; t < 64; ++t) {
            if (t < ntile_eff) {
                unsigned long long m0 = 0ull, m1 = 0ull;
                if (t < ntile) { m0 = __ballot(sc[t].x > T.x); m1 = __ballot(sc[t].y > T.y); }
                if (lane == 0) *(GAS v4u*)(SELQ + ((size_t)(b * 32 + (t >> 1)) * 2 + (t & 1)) * SEQ + s0) = (v4u){(unsigned)m0, (unsigned)m1, (unsigned)(m0 >> 32), (unsigned)(m1 >> 32)};
            }
        }
    } else {
        unsigned run0 = 0u, run1 = 0u;
#pragma nounroll
        for (int tg = 0; tg < 8; ++tg) {
#pragma unroll
            for (int tt = 0; tt < 8; ++tt) {
                f32x2v sv = sc[tt];
#pragma unroll
                for (int g2 = 1; g2 < 8; ++g2) if (tg == g2) sv = sc[g2 * 8 + tt];
                const int t = tg * 8 + tt;
                if (t < ntile_eff) {
                    unsigned long long m0 = 0ull, m1 = 0ull;
                    if (t < ntile) {
                        const unsigned long long e0 = __ballot(sv.x == tv.x), e1 = __ballot(sv.y == tv.y);
                        const unsigned eh0 = hi ? (unsigned)(e0 >> 32) : (unsigned)e0, eh1 = hi ? (unsigned)(e1 >> 32) : (unsigned)e1;
                        const unsigned below = (1u << kl) - 1u;
                        const bool take0 = (sv.x == tv.x) && (run0 + (unsigned)__builtin_popcount(eh0 & below) < need0), take1 = (sv.y == tv.y) && (run1 + (unsigned)__builtin_popcount(eh1 & below) < need1);
                        run0 += (unsigned)__builtin_popcount(eh0); run1 += (unsigned)__builtin_popcount(eh1);
                        m0 = __ballot(sv.x > T.x || take0); m1 = __ballot(sv.y > T.y || take1); }
                    if (lane == 0) *(GAS v4u*)(SELQ + ((size_t)(b * 32 + (t >> 1)) * 2 + (t & 1)) * SEQ + s0) = (v4u){(unsigned)m0, (unsigned)m1, (unsigned)(m0 >> 32), (unsigned)(m1 >> 32)};
                }
            }
        }
    }
}
#ifndef REP_IW
#define REP_IW 1
#endif
#ifndef REP_IST
#define REP_IST 1
#endif
#define IDXREP2(n) _Pragma("nounroll") for (int _r2 = 0, _n2 = ({ int _t = (n); asm volatile("" : "+s"(_t)); _t; }); _r2 < _n2; ++_r2)
DI void indexer_phase(Frame& F) {
#pragma nounroll
    for (int i2 = F.vcu; i2 < 256; i2 += F.G) {
#pragma nounroll
        for (int e = 0; e < 8; ++e) { int b, qb; dsa_unit(i2, e, b, qb);
            const int nkeys = 64 * ((qb >> 1) + 1), tid = F.wave * 64 + lane_id();
            const bf16* KI = (const bf16*)(wsl(F.ws) + WS_KI) + (size_t)b * SEQ * 32;
            IDXREP2(REP_IST) {
            __syncthreads();
#pragma nounroll
            for (int i0 = 0; i0 < nkeys * 4; i0 += 8 * NWAVES * 64) {
                v4u tmp[8];
#pragma unroll
                for (int j = 0; j < 8; ++j) { const int i = i0 + j * NWAVES * 64 + tid; if (i < nkeys * 4) tmp[j] = *(const GAS v4u*)(KI + (size_t)i * 8); }
#pragma unroll
                for (int j = 0; j < 8; ++j) { const int i = i0 + j * NWAVES * 64 + tid, key = i >> 2, c = i & 3; if (i < nkeys * 4) *(LAS v4u*)(F.lds + RING_OFF + key * 64 + ((c ^ ((key >> 2) & 3)) << 4)) = tmp[j]; }
            }
            __syncthreads();
            }
            IDXREP2(REP_IW) { indexer_wave(F, b, qb * 8 + F.wave); } } }
    __syncthreads();
}

constexpr int AD = 128, KVBLK = 64;
constexpr float ATT_SCALE = 0.088388347648318440f, ATT_THR = 8.f;
constexpr size_t SHM_V = KVBLK * AD * 2, SHM_K = KVBLK * AD * 2;
#define KSWZ(row, colB) ((row) * 256 + ((colB) ^ (((row) & 7) << 4)))
typedef __bf16 bf16x2_t __attribute__((ext_vector_type(2)));
DI unsigned cvtpk_c(float lo, float hi_) { f32x2v v = {lo, hi_}; bf16x2_t bb = __builtin_convertvector(v, bf16x2_t); return __builtin_bit_cast(unsigned, bb); }
DI int crow(int r, int hi) { return (r & 3) + 8 * (r >> 2) + 4 * hi; }
DI void partialSM(f32x16& p0, f32x16& p1, float& m_reg, float& mn, float& alpha, unsigned w0, unsigned w1, float tl, float na, int hi) {
    constexpr float C = ATT_SCALE * 1.4426950408889634f;
    const int s0 = (int)(w0 >> (4 * hi)), s1 = (int)(w1 >> (4 * hi)); const float tlh = tl - (float)(4 * hi), tlh1 = tlh - 32.f;
    const int NEGB = 0xF149F2CA;
#pragma unroll
    for (int r = 0; r < 16; ++r) { const int cpos = (r & 3) + 8 * (r >> 2);
        const int m0 = __builtin_amdgcn_sbfe(s0, cpos, 1), m1 = __builtin_amdgcn_sbfe(s1, cpos, 1);
        const float d0 = tlh - (float)cpos, d1 = tlh1 - (float)cpos;
        { const float x0 = fmaf(fabsf(d0), na, p0[r]), x1 = fmaf(fabsf(d1), na, p1[r]); float y0, y1;
          asm("v_bfi_b32 %0, %1, %2, %3" : "=v"(y0) : "v"(m0), "v"(x0), "s"(NEGB)); asm("v_bfi_b32 %0, %1, %2, %3" : "=v"(y1) : "v"(m1), "v"(x1), "s"(NEGB));
          p0[r] = y0; p1[r] = y1; }
        if ((r & 3) == 3) SBAR(); }
    float pmax = p0[0];
#pragma unroll
    for (int r = 1; r < 16; ++r) pmax = fmaxf(pmax, p0[r]);
#pragma unroll
    for (int r = 0; r < 16; ++r) pmax = fmaxf(pmax, p1[r]);
    { auto rr = __builtin_amdgcn_permlane32_swap(__float_as_uint(pmax), __float_as_uint(pmax), false, false);
      pmax = fmaxf(__uint_as_float(rr[0]), __uint_as_float(rr[1])); }
    if (__builtin_expect(__all(pmax - m_reg <= ATT_THR / ATT_SCALE), 1)) { mn = m_reg; alpha = 1.f; }
    else { mn = fmaxf(m_reg, pmax); alpha = __builtin_amdgcn_exp2f((m_reg - mn) * C); m_reg = mn; }
    const float mnC = -mn * C;
#pragma unroll
    for (int r = 0; r < 16; ++r) p0[r] = fmaf(p0[r], C, mnC);
#pragma unroll
    for (int r = 0; r < 16; ++r) p1[r] = fmaf(p1[r], C, mnC);
#pragma unroll
    for (int r = 0; r < 16; ++r) p0[r] = __builtin_amdgcn_exp2f(p0[r]);
}
DI void finishSM(f32x16& p0, f32x16& p1, float alpha, float& l_reg, bf16x8& pa0, bf16x8& pa1, bf16x8& pa2, bf16x8& pa3) {
#pragma unroll
    for (int r = 0; r < 16; ++r) p1[r] = __builtin_amdgcn_exp2f(p1[r]);
    float ps = 0;
#pragma unroll
    for (int r = 0; r < 16; ++r) ps += p0[r];
#pragma unroll
    for (int r = 0; r < 16; ++r) ps += p1[r];
    { auto rr = __builtin_amdgcn_permlane32_swap(__float_as_uint(ps), __float_as_uint(ps), false, false);
      ps = __uint_as_float(rr[0]) + __uint_as_float(rr[1]); }
    l_reg = l_reg * alpha + ps;
#define PK4(P, BASE, OUT) do { unsigned a0 = cvtpk(P[BASE + 0], P[BASE + 1]), a1 = cvtpk(P[BASE + 2], P[BASE + 3]);   \
    unsigned b0 = cvtpk(P[BASE + 4], P[BASE + 5]), b1 = cvtpk(P[BASE + 6], P[BASE + 7]);                              \
    auto r0 = __builtin_amdgcn_permlane32_swap(a0, b0, false, false); auto r1 = __builtin_amdgcn_permlane32_swap(a1, b1, false, false); \
    v4u w = {r0[0], r1[0], r0[1], r1[1]}; OUT = *reinterpret_cast<bf16x8*>(&w); } while (0)
    PK4(p0, 0, pa0); PK4(p0, 8, pa1); PK4(p1, 0, pa2); PK4(p1, 8, pa3);
#undef PK4
}
DI void qkt(f32x16& p0, f32x16& p1, const char* Ks, const bf16x8* qr, int r32, int hi) {
    p0 = f32x16{}; p1 = f32x16{};
#pragma unroll
    for (int d0 = 0; d0 < 8; ++d0) { const int cb = (d0 * 16 + hi * 8) * 2;
        const bf16x8 b0 = *reinterpret_cast<const bf16x8*>(Ks + KSWZ(r32, cb));
        const bf16x8 b1 = *reinterpret_cast<const bf16x8*>(Ks + KSWZ(32 + r32, cb));
        p0 = __builtin_amdgcn_mfma_f32_32x32x16_bf16(b0, qr[d0], p0, 0, 0, 0);
        p1 = __builtin_amdgcn_mfma_f32_32x32x16_bf16(b1, qr[d0], p1, 0, 0, 0); }
}
DI int v_st(int k, int c) { const int kk = (k & ~0xC) | ((k & 4) << 1) | ((k & 8) >> 1); return ((kk >> 3) * 4 + (c >> 5)) * 512 + ((kk & 7) * 32 + (c & 31)) * 2; }
DI int v_rd_base(int lane) { return ((lane & 3) << 3) | (((lane >> 2) & 3) << 6) | (((lane >> 4) & 1) << 5) | (((lane >> 5) & 1) << 8); }
constexpr int v_rd_off(int d0, int ks, int half) { return d0 * 512 + ks * 4096 + half * 2048; }
template <int OFF> DI s16x4 tr_read(int vb) { s16x4 r; asm volatile("ds_read_b64_tr_b16 %0, %1 offset:%2" : "=&v"(r) : "v"(vb), "i"(OFF) : "memory"); return r; }
template <int D0> DI void pv_one(f32x16& od, int vb, bf16x8 pa0, bf16x8 pa1, bf16x8 pa2, bf16x8 pa3) {
    const s16x4 l0 = tr_read<v_rd_off(D0, 0, 0)>(vb), h0 = tr_read<v_rd_off(D0, 0, 1)>(vb), l1 = tr_read<v_rd_off(D0, 1, 0)>(vb), h1 = tr_read<v_rd_off(D0, 1, 1)>(vb);
    const s16x4 l2 = tr_read<v_rd_off(D0, 2, 0)>(vb), h2 = tr_read<v_rd_off(D0, 2, 1)>(vb), l3 = tr_read<v_rd_off(D0, 3, 0)>(vb), h3 = tr_read<v_rd_off(D0, 3, 1)>(vb);
    asm volatile("s_waitcnt lgkmcnt(0)" ::: "memory"); SBAR();
#define PKV(L, H) (bf16x8){L[0], L[1], L[2], L[3], H[0], H[1], H[2], H[3]}
    od = __builtin_amdgcn_mfma_f32_32x32x16_bf16(PKV(l0, h0), pa0, od, 0, 0, 0);
    od = __builtin_amdgcn_mfma_f32_32x32x16_bf16(PKV(l1, h1), pa1, od, 0, 0, 0);
    od = __builtin_amdgcn_mfma_f32_32x32x16_bf16(PKV(l2, h2), pa2, od, 0, 0, 0);
    od = __builtin_amdgcn_mfma_f32_32x32x16_bf16(PKV(l3, h3), pa3, od, 0, 0, 0);
#undef PKV
}
DI void pv_d0(f32x16* o, int vb, bf16x8 pa0, bf16x8 pa1, bf16x8 pa2, bf16x8 pa3) {
    pv_one<0>(o[0], vb, pa0, pa1, pa2, pa3); pv_one<1>(o[1], vb, pa0, pa1, pa2, pa3); pv_one<2>(o[2], vb, pa0, pa1, pa2, pa3); pv_one<3>(o[3], vb, pa0, pa1, pa2, pa3);
}
DI void attn_unit(Frame& F, int F_layer, int b, int qb, char* lds) {
    const int wid = F.wave, lane = lane_id(), tid = wid * 64 + lane, r32 = lane & 31, hi = lane >> 5;
    const bf16* QQ = (const bf16*)(wsl(F.ws) + WS_QQ); const bf16* Kh = (const bf16*)(wsl(F.ws) + WS_CKVN) + (size_t)b * SEQ * AD; const unsigned* SELQ = (const unsigned*)(wsl(F.ws) + WS_SELQ);
    bf16* YC = (bf16*)(wsl(F.ws) + WS_YC);
    char* V_lds = lds; char* K_lds = lds + 2 * SHM_V;
    float m_reg = -1e6f, l_reg = 0; f32x16 o[4] = {}; bf16x8 qr[8];
    const int sq = qb * 32 + r32;
    const bf16* Qw = QQ + ((size_t)b * SEQ + sq) * 1280 + wid * AD + hi * 8;
#pragma unroll
    for (int d0 = 0; d0 < 8; ++d0) qr[d0] = *(const GAS bf16x8*)(Qw + d0 * 16);
    int NT = (qb >> 1) + 1; NT += NT & 1;
    int wl = wid + 1; asm volatile("" : "+s"(wl));
    const float na = -exp2f(-(float)wl) / ATT_SCALE, tq = (float)sq;
    const GAS unsigned* selp = (const GAS unsigned*)SELQ + (size_t)b * 32 * 2 * SEQ + sq;
    const int sr = tid >> 4, scc = (tid & 15) * 8, vst0 = v_st(sr, scc), vst1 = v_st(32 + sr, scc);
    const int vb0 = (int)(uintptr_t)V_lds + v_rd_base(lane);
    bf16x8 st0[2], st1[2];
#define SLOAD(i, k0) do { st0[i] = *(const GAS bf16x8*)(Kh + (size_t)((k0) + sr) * AD + scc); st1[i] = *(const GAS bf16x8*)(Kh + (size_t)((k0) + 32 + sr) * AD + scc); } while (0)
#define SWRITE(bb, i) do { *(bf16x8*)(V_lds + (bb) * SHM_V + vst0) = st0[i]; *(bf16x8*)(V_lds + (bb) * SHM_V + vst1) = st1[i]; const int kc = scc * 2; \
    *(bf16x8*)(K_lds + (bb) * SHM_K + KSWZ(sr, kc)) = st0[i]; *(bf16x8*)(K_lds + (bb) * SHM_K + KSWZ(32 + sr, kc)) = st1[i]; } while (0)
#define SWAIT() asm volatile("s_waitcnt vmcnt(2)" ::: "memory")
#define RESC(a) do { if (__any((a) < 1.f)) { _Pragma("unroll") for (int d = 0; d < 4; ++d) _Pragma("unroll") for (int r = 0; r < 16; ++r) o[d][r] *= (a); } } while (0)
#define MASKW(j, wa, wb) do { wa = selp[(size_t)((j) * 2) * SEQ]; wb = selp[(size_t)((j) * 2 + 1) * SEQ]; } while (0)
    f32x16 pA0, pA1, pB0, pB1; float mnA, mnB, alA, alB; bf16x8 pa0, pa1, pa2, pa3; unsigned wA0, wA1, wB0, wB1;
    constexpr int SE = 0, SO = 1;
    MASKW(0, wA0, wA1);
    SLOAD(SE, 0); asm volatile("s_waitcnt vmcnt(0)" ::: "memory"); SWRITE(0, SE); __syncthreads();
    qkt(pA0, pA1, K_lds, qr, r32, hi); partialSM(pA0, pA1, m_reg, mnA, alA, wA0, wA1, tq, na, hi);
    SLOAD(SO, KVBLK); if (2 < NT) SLOAD(SE, 2 * KVBLK);
    asm volatile("s_waitcnt vmcnt(2)" ::: "memory"); SWRITE(1, SO); __syncthreads();
    for (int j = 1; j + 1 < NT; j += 2) {
        MASKW(j, wB0, wB1);
        SBAR(); qkt(pB0, pB1, K_lds + SHM_K, qr, r32, hi);
        finishSM(pA0, pA1, alA, l_reg, pa0, pa1, pa2, pa3); SBAR();
        SLOAD(SO, (j + 2) * KVBLK); SBAR();
        pv_d0(o, vb0, pa0, pa1, pa2, pa3); partialSM(pB0, pB1, m_reg, mnB, alB, wB0, wB1, tq - (float)(64 * j), na, hi);
        __syncthreads(); SWAIT(); SWRITE(0, SE);
        RESC(alB); __syncthreads();
        MASKW(j + 1, wA0, wA1);
        SBAR(); qkt(pA0, pA1, K_lds, qr, r32, hi);
        finishSM(pB0, pB1, alB, l_reg, pa0, pa1, pa2, pa3); SBAR();
        if (j + 3 < NT) SLOAD(SE, (j + 3) * KVBLK); SBAR();
        pv_d0(o, vb0 + (int)SHM_V, pa0, pa1, pa2, pa3); partialSM(pA0, pA1, m_reg, mnA, alA, wA0, wA1, tq - (float)(64 * (j + 1)), na, hi);
        __syncthreads(); if (j + 3 < NT) SWAIT(); else asm volatile("s_waitcnt vmcnt(0)" ::: "memory"); SWRITE(1, SO);
        RESC(alA); __syncthreads();
    }
    MASKW(NT - 1, wB0, wB1);
    SBAR(); qkt(pB0, pB1, K_lds + SHM_K, qr, r32, hi);
    finishSM(pA0, pA1, alA, l_reg, pa0, pa1, pa2, pa3); SBAR();
    pv_d0(o, vb0, pa0, pa1, pa2, pa3); partialSM(pB0, pB1, m_reg, mnB, alB, wB0, wB1, tq - (float)(64 * (NT - 1)), na, hi);
    __syncthreads(); RESC(alB);
    finishSM(pB0, pB1, alB, l_reg, pa0, pa1, pa2, pa3); SBAR();
    pv_d0(o, vb0 + (int)SHM_V, pa0, pa1, pa2, pa3);
    { const float inv = __builtin_amdgcn_rcpf(l_reg) * (MERGE_FP8 ? Y8_SCALE : 1.0f);
      f32x16 y0 = {}, y1 = {};
      const bf16* wf = wslot(F, F_layer, W_UVF) + ((size_t)(wid * 16) * 64 + lane) * 8;
      bf16x8 af[16];
#pragma unroll
      for (int i = 0; i < 16; ++i) af[i] = *(const GAS bf16x8*)(wf + (size_t)(i * 64) * 8);
      asm volatile("" ::: "memory");
#pragma unroll
      for (int d0 = 0; d0 < 4; ++d0)
#pragma unroll
          for (int sx = 0; sx < 2; ++sx) {
              v4u pk; pk.x = cvtpk_c(o[d0][8 * sx + 0] * inv, o[d0][8 * sx + 1] * inv); pk.y = cvtpk_c(o[d0][8 * sx + 2] * inv, o[d0][8 * sx + 3] * inv);
              pk.z = cvtpk_c(o[d0][8 * sx + 4] * inv, o[d0][8 * sx + 5] * inv); pk.w = cvtpk_c(o[d0][8 * sx + 6] * inv, o[d0][8 * sx + 7] * inv);
              const bf16x8 xb = *reinterpret_cast<bf16x8*>(&pk);
              const bf16x8 a0 = af[0 * 8 + d0 * 2 + sx], a1 = af[1 * 8 + d0 * 2 + sx];
              y0 = __builtin_amdgcn_mfma_f32_32x32x16_bf16(a0, xb, y0, 0, 0, 0);
              y1 = __builtin_amdgcn_mfma_f32_32x32x16_bf16(a1, xb, y1, 0, 0, 0); }
      if (MERGE_FP8) { GAS unsigned char* yp8 = (GAS unsigned char*)YC + ((size_t)b * SEQ + sq) * 1024 + wid * 64 + 32 * hi;
          unsigned w[8];
#pragma unroll
          for (int g = 0; g < 4; ++g) { int p0 = __builtin_amdgcn_cvt_pk_fp8_f32(pg8::sat8(y0[4 * g]), pg8::sat8(y0[4 * g + 1]), 0, false); p0 = __builtin_amdgcn_cvt_pk_fp8_f32(pg8::sat8(y0[4 * g + 2]), pg8::sat8(y0[4 * g + 3]), p0, true);
              int p1 = __builtin_amdgcn_cvt_pk_fp8_f32(pg8::sat8(y1[4 * g]), pg8::sat8(y1[4 * g + 1]), 0, false); p1 = __builtin_amdgcn_cvt_pk_fp8_f32(pg8::sat8(y1[4 * g + 2]), pg8::sat8(y1[4 * g + 3]), p1, true);
              const auto rr = __builtin_amdgcn_permlane32_swap((unsigned)p0, (unsigned)p1, false, false); w[2 * g] = rr[0]; w[2 * g + 1] = rr[1]; }
          *(GAS v4u*)(yp8) = (v4u){w[0], w[1], w[2], w[3]}; *(GAS v4u*)(yp8 + 16) = (v4u){w[4], w[5], w[6], w[7]}; }
      else {
      bf16* yp = YC + ((size_t)b * SEQ + sq) * 1024 + wid * 64 + 4 * hi;
#pragma unroll
      for (int g = 0; g < 4; ++g) { u32x2v w0, w1; w0.x = cvtpk_c(y0[4 * g], y0[4 * g + 1]); w0.y = cvtpk_c(y0[4 * g + 2], y0[4 * g + 3]); w1.x = cvtpk_c(y1[4 * g], y1[4 * g + 1]); w1.y = cvtpk_c(y1[4 * g + 2], y1[4 * g + 3]);
          *(GAS u32x2v*)(yp + 8 * g) = w0; *(GAS u32x2v*)(yp + 32 + 8 * g) = w1; } } }
    __syncthreads();
#undef SLOAD
#undef SWRITE
#undef SWAIT
#undef RESC
#undef MASKW
}
DI void attn_phase(Frame& F, int layer) {
#pragma nounroll
    for (int i2 = F.vcu; i2 < 256; i2 += F.G) {
#pragma nounroll
        for (int e = 0; e < 8; ++e) { int b, qb; dsa_unit(i2, e, b, qb); attn_unit(F, layer, b, qb, (char*)(F.lds + RING_OFF)); } }
}

#ifndef REP_GEMM
#define REP_GEMM 1
#endif
#ifndef REP_ATT
#define REP_ATT 1
#endif
#ifndef REP_THIN
#define REP_THIN 1
#endif
#ifndef REP_P0
#define REP_P0 1
#endif
#ifndef REP_NORM
#define REP_NORM 1
#endif
#ifndef REP_IDX
#define REP_IDX 1
#endif
#ifndef REP_EXP
#define REP_EXP 1
#endif
#ifndef REP_N9
#define REP_N9 1
#endif
#ifndef REP_G7
#define REP_G7 1
#endif
#ifndef REP_G9
#define REP_G9 1
#endif
#ifndef REP_BAR
#define REP_BAR 1
#endif
#ifndef REP_G8
#define REP_G8 1
#endif
#ifndef REP_G12
#define REP_G12 1
#endif
#ifndef REP_S5
#define REP_S5 1
#endif
#ifndef STAGGER_US
#define STAGGER_US 0
#endif
#define STAGGER() do { if (STAGGER_US > 0 && (F.vcu & 1)) { _Pragma("nounroll") for (int _i = 0; _i < STAGGER_US / 4; ++_i) __builtin_amdgcn_s_sleep(127); } } while (0)
#define REPEAT(n) _Pragma("nounroll") for (int _r = 0, _n = ({ int _t = (n); asm volatile("" : "+s"(_t)); _t; }); _r < _n; ++_r)
#ifndef PHMASK
#define PHMASK 0xFFFFFFFF
#endif
#define PH(n) (((PHMASK) >> (n)) & 1)
#ifndef FEAT_MIXER
#define FEAT_MIXER 1
#endif
__global__ void __launch_bounds__(NWAVES * 64, 2) fwd_kernel(Args args) {
    extern __shared__ __attribute__((aligned(16))) unsigned char lds[];
    Frame F;
    F.lds = (LAS unsigned char*)lds;
    F.MISC = (volatile LAS unsigned*)(F.lds + MISC_OFF);
    F.wave = __builtin_amdgcn_readfirstlane((int)threadIdx.x >> 6);
    F.G = gridDim.x; { const int bx = blockIdx.x; F.vcu = (F.G % 8 == 0) ? (bx % 8) * (F.G / 8) + bx / 8 : bx; }
    F.ws = args.ws; F.out = args.out;
    F.ctl = (gu32*)(args.ws + WS_CTL);
    for (int u = (int)threadIdx.x; u < (LDS_BYTES - LDSCTL_OFF) / 4; u += NWAVES * 64) ((LAS unsigned*)(F.lds + LDSCTL_OFF))[u] = 0u;
    __syncthreads();
    (void)xcd_barrier_post((unsigned*)(F.ctl + CW_BAR), F.MISC + 8);
#define GRID_BAR() do { XcdBarrier _b; _b.bar = (unsigned*)((gu32*)(wsl(args.ws) + WS_CTL) + CW_BAR); _b.x = xb_xcc_id(); _b.wave = F.wave; _b.st = (volatile LAS unsigned*)(F.lds + MISC_OFF) + 8; REPEAT(REP_BAR) { xcd_barrier(_b); } } while (0)
    using namespace pg8;
    unsigned char* ws = args.ws;
    const int bx = (int)blockIdx.x;
#define LBX() ({ int _b = bx; asm volatile("" : "+s"(_b)); _b; })

    REPEAT(REP_P0) { if (PH(0)) p0_prologue(F, args); }
    GRID_BAR();
    REPEAT(REP_P0) { if (PH(1)) p1_kt(F, args); }
    REPEAT(REP_NORM)
    { const float* mod0 = (const float*)(wsl(ws) + WS_MOD);
      if (PH(9)) { _Pragma("nounroll") for (int pm = F.vcu; pm < MTOK / 256; pm += F.G) norm_panel(F, pm, args.in[I_X], nullptr, nullptr, nullptr, nullptr, args.in[I_MIXPRE], mod0 + 1 * DM, mod0 + 0 * DM, (bf16*)(wsl(ws) + WS_H), false, 0); } }
    GRID_BAR();

    for (int l = 0; l < DEPTH; ++l) {
        const float* mod = (const float*)(wsl(ws) + WS_MOD) + (size_t)l * BATCH * NMOD;
        const float* xin = (l == 0) ? args.in[I_X] : F.out;
#if FEAT_MIXER
        REPEAT(REP_EXP) { if (PH(2)) s5_expand(F, args, l); }
REPEAT(REP_GEMM) {
        STAGGER();
#if IN_FP8
        { constexpr int NG = SMALL_FP8 ? 3584 : 3072;
          Gemm g{(const bf16_t*)(wsl(ws) + WS_H8), (const bf16_t*)wslot(F, l, W_IN), MTOK, NG, DM / 2, DM / 2, DM / 2}; StaticOrder S; S.init(MTOK, NG, F.G, LBX());
          EpiBf16<2> E{(bf16_t*)(wsl(ws) + WS_ZG), 1024, nullptr, 1024, (size_t)MTOK * 1024, 1.f, 1.0f / W8_SCALE, 3, 512};
          if (PH(10)) gemm_phase<EpiBf16<2>, StaticOrder, true, true, true>(F.lds + RING_OFF, g, S, E, F.wave); }
        { constexpr int NS = SMALL_FP8 ? 512 : 1024;
          Gemm g{(const bf16_t*)(wsl(ws) + WS_H), (const bf16_t*)wslot(F, l, W_IN) + (size_t)3072 * DM, MTOK, NS, DM, DM, DM}; StaticOrder S; S.init(MTOK, NS, F.G, LBX());
          EpiBf16<0> E{(bf16_t*)(wsl(ws) + WS_ZS), 1024, nullptr, 0, 0, 1.f};
          if (PH(10)) gemm_phase<EpiBf16<0>, StaticOrder, true, true>(F.lds + RING_OFF, g, S, E, F.wave); }
#else
        { Gemm g{(const bf16_t*)(wsl(ws) + WS_H), (const bf16_t*)wslot(F, l, W_IN), MTOK, 4096, DM, DM, DM}; StaticOrder S; S.init(MTOK, 4096, F.G, LBX());
          EpiBf16<0> E{(bf16_t*)(wsl(ws) + WS_ZG), 1024, nullptr, 1024, (size_t)MTOK * 1024, 1.f};
          if (PH(10)) gemm_phase<EpiBf16<0>, StaticOrder, true, true>(F.lds + RING_OFF, g, S, E, F.wave); }
#endif
        }
        GRID_BAR();
REPEAT(REP_THIN) {
        if (PH(3)) small_ops(F, args, l);
        }
        GRID_BAR();
REPEAT(REP_S5) {
        { Gemm g{(const bf16_t*)(wsl(ws) + WS_AS5), (const bf16_t*)(wsl(ws) + WS_WE), 16384, 4096, 1024, AS5_LD, 1024}; GroupOrder<1> S{F.G, LBX()};
          EpiE E{(float*)(wsl(ws) + WS_E)};
          if (PH(11)) gemm_phase<EpiE, GroupOrder<1>, false, true>(F.lds + RING_OFF, g, S, E, F.wave); }
        { Gemm g{(const bf16_t*)(wsl(ws) + WS_POOLED), (const bf16_t*)wslot(F, l, W_POOL), MTOK, 256, 256, 256, 256}; StaticOrder S; S.init(MTOK, 256, F.G, LBX());
#if MERGE_FP8
          EpiF8 E{(unsigned char*)(wsl(ws) + WS_YC) + 768, 1024, Y8_SCALE};
          if (PH(12)) gemm_phase<EpiF8, StaticOrder, true, true>(F.lds + RING_OFF, g, S, E, F.wave); }
#else
          EpiBf16<0> E{(bf16_t*)(wsl(ws) + WS_YC) + 768, 1024, nullptr, 0, 0, 1.f};
          if (PH(12)) gemm_phase<EpiBf16<0>, StaticOrder, true, true>(F.lds + RING_OFF, g, S, E, F.wave); }
#endif
        { Gemm g{(const bf16_t*)(wsl(ws) + WS_CQN), (const bf16_t*)wslot(F, l, W_Q), MTOK, 1280, 256, 256, 256}; QQOrder S{F.G, LBX()};
          EpiBf16<0> E{(bf16_t*)(wsl(ws) + WS_QQ), 1280, nullptr, 0, 0, 1.f};
          if (PH(13)) gemm_phase<EpiBf16<0>, QQOrder, true, true>(F.lds + RING_OFF, g, S, E, F.wave); }
        }
        GRID_BAR();
REPEAT(REP_S5) {
        if (PH(4)) s5_scan(F, l);
        }
REPEAT(REP_IDX) {
        if (PH(5)) indexer_phase(F);
        }
        GRID_BAR();
REPEAT(REP_S5) {
        { Gemm g{(const bf16_t*)(wsl(ws) + WS_AS5), (const bf16_t*)(wsl(ws) + WS_WY), 16384, 16384, AS5_LD, AS5_LD, AS5_LD}; GroupOrder<4> S{F.G, LBX()};
          EpiS5Y E{(bf16_t*)(wsl(ws) + WS_ZSS)};
          if (PH(14)) gemm_phase<EpiS5Y, GroupOrder<4>, false, true>(F.lds + RING_OFF, g, S, E, F.wave); }
        }
REPEAT(REP_ATT) {
        if (PH(6)) attn_phase(F, l);
        }
        GRID_BAR();
#pragma nounroll
        for (int pm = F.vcu; pm < MTOK / 256; pm += F.G) {
            { Gemm g{(const bf16_t*)(wsl(ws) + WS_ZSS), (const bf16_t*)wslot(F, l, W_GLU), MTOK, 256, 256, 256, 256}; PanelOrder S{pm, 1};
              EpiGlu E{(const bf16_t*)(wsl(ws) + WS_ZSS), MERGE_FP8 ? (bf16_t*)((unsigned char*)(wsl(ws) + WS_YC) + 512) : (bf16_t*)(wsl(ws) + WS_YC) + 512, args.in[I_BGLU] + l * 256, 1024};
              REPEAT(REP_G7) { if (PH(15)) gemm_phase<EpiGlu, PanelOrder, true, true>(F.lds + RING_OFF, g, S, E, F.wave); } }
            panel_sync();
            { constexpr int KM = MERGE_FP8 ? DM / 2 : DM;
              Gemm g{(const bf16_t*)(wsl(ws) + WS_YC), (const bf16_t*)wslot(F, l, W_M), MTOK, DM, KM, KM, KM}; PanelOrder S{pm, 4};
              EpiMerge E{(const bf16_t*)(wsl(ws) + WS_ZG), (bf16_t*)(wsl(ws) + WS_MG), (size_t)MTOK * 1024, MERGE_FP8 ? 1.0f / (W8_SCALE * Y8_SCALE) : 1.f};
              REPEAT(REP_G8) { if (PH(16)) gemm_phase<EpiMerge, PanelOrder, true, true, MERGE_FP8 != 0>(F.lds + RING_OFF, g, S, E, F.wave); } }
            panel_sync();
            { constexpr int KO = OUT_FP8 ? DM / 2 : DM;
              Gemm g{(const bf16_t*)(wsl(ws) + WS_MG), (const bf16_t*)wslot(F, l, W_OUT), MTOK, DM, KO, KO, KO}; PanelOrder S{pm, 4};
              EpiBf16<0> E{(bf16_t*)(wsl(ws) + WS_Y), DM, nullptr, 0, 0, 1.f, OUT_FP8 ? 1.0f / W8_SCALE : 1.f};
              REPEAT(REP_G9) { if (PH(19)) gemm_phase<EpiBf16<0>, PanelOrder, true, true, OUT_FP8 != 0>(F.lds + RING_OFF, g, S, E, F.wave); } }
            panel_sync();
            REPEAT(l == 0 ? REP_N9 : 1) if (PH(9)) norm_panel(F, pm, xin, (const bf16*)(wsl(ws) + WS_Y), mod + 2 * DM, args.in[I_MIXPOST] + l * DM, F.out, args.in[I_FFNPRE] + l * DM, mod + 4 * DM, mod + 3 * DM, (bf16*)(wsl(ws) + WS_H), true, (l == 0 ? 0 : 1) | 2);
        }
        GRID_BAR();
#else
        { const int gw = F.vcu * NWAVES + F.wave, NGW = F.G * NWAVES;
          if (l == 0) for (int m = gw; m < MTOK; m += NGW) { const GAS f32x4* xr = (const GAS f32x4*)(xin + (size_t)m * DM) + lane_id(); GAS f32x4* xo = (GAS f32x4*)(F.out + (size_t)m * DM) + lane_id();
#pragma unroll
              for (int j = 0; j < 4; ++j) xo[64 * j] = xr[64 * j]; } }
        if (PH(9)) norm_rows(F, xin, nullptr, nullptr, nullptr, nullptr, args.in[I_FFNPRE] + l * DM, mod + 4 * DM, mod + 3 * DM, (bf16*)(wsl(ws) + WS_H));
        GRID_BAR();
#endif
REPEAT(REP_GEMM) {
        STAGGER();
        { constexpr int KU = UP_FP8 ? DM / 2 : DM;
          Gemm g{(const bf16_t*)(wsl(ws) + WS_H), (const bf16_t*)wslot(F, l, W_UP), MTOK, 4096, KU, KU, KU}; StaticOrder S; S.init(MTOK, 4096, F.G, LBX());
          EpiConv E{args.in[I_CONVW] + (size_t)l * 3 * 4096, args.in[I_CONVB] + (size_t)l * 4096, (bf16_t*)(wsl(ws) + WS_A2), (float*)(wsl(ws) + WS_HALO), UP_FP8 ? 1.0f / W8_SCALE : 1.f};
          if (PH(20)) gemm_phase<EpiConv, StaticOrder, true, true, UP_FP8 != 0>(F.lds + RING_OFF, g, S, E, F.wave); }
        }
        GRID_BAR();
#pragma nounroll
        for (int pm = F.vcu; pm < MTOK / 256; pm += F.G) {
            REPEAT(REP_G12) { if (PH(7)) conv_fixup(F, args, l, pm); }
            panel_sync();
            { constexpr int KV = DOWN_FP8 ? DFF / 2 : DFF;
              Gemm g{(const bf16_t*)(wsl(ws) + WS_A2), (const bf16_t*)wslot(F, l, W_DOWN), MTOK, DM, KV, KV, KV}; PanelOrder S{pm, 4};
              EpiBf16<0> E{(bf16_t*)(wsl(ws) + WS_Y2), DM, nullptr, 0, 0, 1.f, DOWN_FP8 ? 1.0f / W8_SCALE : 1.f};
              REPEAT(REP_G12) { if (PH(21)) gemm_phase<EpiBf16<0>, PanelOrder, true, true, DOWN_FP8 != 0>(F.lds + RING_OFF, g, S, E, F.wave); } }
            panel_sync();
            if (l + 1 < DEPTH) { const float* modn = mod + (size_t)BATCH * NMOD;
                norm_panel(F, pm, F.out, (const bf16*)(wsl(ws) + WS_Y2), mod + 5 * DM, args.in[I_FFNPOST] + l * DM, F.out, args.in[I_MIXPRE] + (l + 1) * DM, modn + 1 * DM, modn + 0 * DM, (bf16*)(wsl(ws) + WS_H), false, 3); }
            else norm_panel(F, pm, F.out, (const bf16*)(wsl(ws) + WS_Y2), mod + 5 * DM, args.in[I_FFNPOST] + l * DM, F.out, nullptr, nullptr, nullptr, nullptr, false, 1);
        }
        if (l + 1 < DEPTH) GRID_BAR();
    }
}

extern "C" void kernel_launch(void* const* d_in, const int* in_sizes, int n_in, void* d_out, int out_size, void* d_ws, size_t ws_size, hipStream_t stream) {
    static int grid = 0;
    if (grid == 0) {
        if (n_in != N_INPUTS || out_size != MTOK * DM || ws_size < WS_END) { fprintf(stderr, "kernel_launch: unexpected shapes: n_in %d out %d ws %zu (need %zu)\n", n_in, out_size, ws_size, (size_t)WS_END); grid = -1; return; }
        int dev = 0, cus = 0;
        if (hipGetDevice(&dev) != hipSuccess || hipDeviceGetAttribute(&cus, hipDeviceAttributeMultiprocessorCount, dev) != hipSuccess) { grid = -1; return; }
        if (hipFuncSetAttribute((const void*)fwd_kernel, hipFuncAttributeMaxDynamicSharedMemorySize, LDS_BYTES) != hipSuccess) { fprintf(stderr, "kernel_launch: hipFuncSetAttribute failed\n"); grid = -1; return; }
        int per_cu = 0;
        if (hipOccupancyMaxActiveBlocksPerMultiprocessor(&per_cu, (const void*)fwd_kernel, NWAVES * 64, LDS_BYTES) != hipSuccess || per_cu < 1) { fprintf(stderr, "kernel_launch: occupancy query says %d\n", per_cu); }
        (void)hipGetLastError();
        grid = cus;
    }
    if (grid < 0) return;
    (void)hipMemsetAsync((char*)d_ws + WS_CTL, 0, CTL_ZERO_BYTES, stream);
    Args a{};
    for (int i = 0; i < N_INPUTS; ++i) a.in[i] = (const float*)d_in[i];
    a.out = (float*)d_out; a.ws = (unsigned char*)d_ws; a.ph_lo = 0; a.ph_hi = 0; a.li = 0; a.pad = 0;
    hipLaunchKernelGGL(fwd_kernel, dim3(grid), dim3(NWAVES * 64), LDS_BYTES, stream, a);
}
```

```cpp
#include <hip/hip_runtime.h>
#include <cstdio>
#include <cstdint>
#ifndef DOWN_FP8
#define DOWN_FP8 1
#endif
#ifndef UP_FP8
#define UP_FP8 1
#endif
#ifndef IN_FP8
#define IN_FP8 1
#endif
#ifndef OUT_FP8
#define OUT_FP8 1
#endif
#ifndef MERGE_FP8
#define MERGE_FP8 1
#endif
#define Y8_SCALE 4.0f
#ifndef SMALL_FP8
#define SMALL_FP8 1
#endif
#ifndef PAIR_GATES
#define PAIR_GATES 1
#endif
#define W8_SCALE 32.0f
namespace pg8 {
#define PG8_LAS __attribute__((address_space(3)))
#define PG8_GAS __attribute__((address_space(1)))
typedef unsigned short bf16_t;
typedef short bf16x8 __attribute__((ext_vector_type(8)));
typedef float f32x4 __attribute__((ext_vector_type(4)));
typedef unsigned u32x4 __attribute__((ext_vector_type(4)));
constexpr int BM = 256, BK = 64, HALF = 128, HTB = HALF * BK * 2  , STAGE_BYTES = 8 * HTB, NXCD = 8, WGM = 8;

__host__ __device__ __forceinline__ int lds_byte(int r, int c) { const int st = (r >> 4) * 2 + (c >> 5), rr = r & 15, cc = c & 31, ob = rr * 64 + cc * 2; return st * 1024 + (ob ^ (((ob >> 9) & 1) << 5)); }
__host__ __device__ __forceinline__ void stage_rc(int b, int& R, int& C) { const int st = b / 1024, sb = b % 1024, swz = sb ^ (((sb >> 9) & 1) << 5); R = (st >> 1) * 16 + swz / 64; C = (st & 1) * 32 + (swz % 64) / 2; }
__host__ __device__ __forceinline__ int perm32(int rho) { const int n = rho >> 4, i = rho & 15; return 8 * (i >> 2) + 4 * n + (i & 3); }

struct Unit { int pm, pn; };
__device__ __forceinline__ float sat8(float x) { return __builtin_amdgcn_fmed3f(x, -448.0f, 448.0f); }
typedef int i32x4_ __attribute__((ext_vector_type(4)));
typedef int i32x8_ __attribute__((ext_vector_type(8)));
__device__ __forceinline__ i32x8_ cat8(bf16x8 lo, bf16x8 hi) { const i32x4_ a = __builtin_bit_cast(i32x4_, lo), b = __builtin_bit_cast(i32x4_, hi); return __builtin_shufflevector(a, b, 0, 1, 2, 3, 4, 5, 6, 7); }
struct Gemm { const bf16_t* A; const bf16_t* Bt; int M, N, K, lda, ldb; };

struct StaticOrder {
    int nM, nN, nwg, G, c;
    __host__ __device__ void init(int M, int N, int G_, int c_) { nM = M / BM; nN = N / BM; nwg = nM * nN; G = G_; c = c_; }
    __host__ __device__ bool next(int i, Unit& u) const {
        const long L = (long)i * G + c; if (L >= nwg) return false;
        int wgid = (int)L; { const int q = nwg / NXCD, r = nwg % NXCD, xcd = wgid % NXCD, off = wgid / NXCD; wgid = (xcd < r ? xcd * (q + 1) : r * (q + 1) + (xcd - r) * q) + off; }
        const int nig = WGM * nN, gid = wgid / nig, fm = gid * WGM, gsz = (nM - fm) < WGM ? (nM - fm) : WGM;
        u.pm = fm + ((wgid % nig) % gsz); u.pn = (wgid % nig) / gsz; return true;
    }
    __device__ __forceinline__ void a_ready(const Unit&) const {}
    __device__ __forceinline__ void done(const Unit&) const {}
};

__device__ __forceinline__ unsigned cvt_pk_bf16(float lo, float hi) { unsigned r; asm volatile("v_cvt_pk_bf16_f32 %0, %1, %2" : "=v"(r) : "v"(lo), "v"(hi)); return r; }
typedef float f32x2 __attribute__((ext_vector_type(2)));
__device__ __forceinline__ f32x2 gelu_pk(f32x2 v) {
    const f32x2 av = __builtin_elementwise_abs(v), d = av * 0.2316418882f + 1.0f;
    f32x2 t; t.x = __builtin_amdgcn_rcpf(d.x); t.y = __builtin_amdgcn_rcpf(d.y);
    f32x2 q = t * 0.5307027145f + (-0.7265760135f); q = q * t + 0.7107068705f; q = q * t + (-0.142248368f); q = q * t + 0.127414796f; q = q * t;
    const f32x2 s = (v * v) * (-0.72134752044f);
    f32x2 e; e.x = __builtin_amdgcn_exp2f(s.x); e.y = __builtin_amdgcn_exp2f(s.y);
    const f32x2 m = v * (q * e), r = v - m;
    f32x2 o; o.x = v.x < 0.f ? m.x : r.x; o.y = v.y < 0.f ? m.y : r.y; return o;
}

typedef __bf16 bf16x2c_ __attribute__((ext_vector_type(2)));
__device__ __forceinline__ unsigned cvt_pk_bf16_c(float lo, float hi) { f32x2 v = {lo, hi}; bf16x2c_ b = __builtin_convertvector(v, bf16x2c_); return __builtin_bit_cast(unsigned, b); }
template <int ACT  > struct EpiBf16 {
    static constexpr bool PERM = true, AFTER_DRAIN = false, MID = false; static_assert(ACT == 0 || ACT == 1 || ACT == 2, "EpiBf16: ACT is 0 (none), 1 (gelu_pk) or 2 (exp(-x) of the scaled value: gate logits stored as E = e^-z, so that sigmoid = 1/(1+E) and gate ratios need no exponentials later)");
    bf16_t* O; int ldc; const float* bias; int split_cols; size_t split_stride; float scale0; float scale_all = 1.f; int plain_t = 1 << 30, plain_col = 0;
    __device__ __forceinline__ void operator()(const f32x4 (&acc)[2][2][4][2], const Unit& u, int wr, int wc, int fr, int fq) const {
        const int row0 = u.pm * BM + wr * 64 + fr; int colt = u.pn * BM; bf16_t* base = O;
        float sc = scale_all; bool act = true; if (split_cols) { const int t = colt / split_cols; base += (size_t)t * split_stride; colt -= t * split_cols; if (t == 0) sc *= scale0; if (t >= plain_t) { colt += plain_col; act = false; } }
        const int col0 = colt + wc * 32 + 8 * fq, bcol0 = u.pn * BM + wc * 32 + 8 * fq;
        f32x4 bv[2][2];
#pragma unroll
        for (int bj = 0; bj < 2; ++bj)
#pragma unroll
            for (int n = 0; n < 2; ++n) bv[bj][n] = bias ? *(const PG8_GAS f32x4*)(bias + bcol0 + bj * HALF + 4 * n) : (f32x4){0.f, 0.f, 0.f, 0.f};
#pragma unroll
        for (int ai = 0; ai < 2; ++ai)
#pragma unroll
            for (int m = 0; m < 4; ++m) { bf16_t* rowp = base + (size_t)(row0 + ai * HALF + m * 16) * ldc + col0;
#pragma unroll
                for (int bj = 0; bj < 2; ++bj) { f32x4 v0 = acc[ai][bj][m][0] + bv[bj][0], v1 = acc[ai][bj][m][1] + bv[bj][1];
                    if (ACT == 1) { f32x2 a = gelu_pk((f32x2){v0[0], v0[1]}), b = gelu_pk((f32x2){v0[2], v0[3]}), c = gelu_pk((f32x2){v1[0], v1[1]}), d = gelu_pk((f32x2){v1[2], v1[3]});
                        v0 = (f32x4){a.x, a.y, b.x, b.y}; v1 = (f32x4){c.x, c.y, d.x, d.y}; }
                    v0 = v0 * sc; v1 = v1 * sc;
                    if (ACT == 2 && act) {
#pragma unroll
                        for (int q = 0; q < 4; ++q) { v0[q] = __builtin_amdgcn_exp2f(-1.4426950408889634f * __builtin_amdgcn_fmed3f(v0[q], -30.0f, 30.0f)); v1[q] = __builtin_amdgcn_exp2f(-1.4426950408889634f * __builtin_amdgcn_fmed3f(v1[q], -30.0f, 30.0f)); } }
                    u32x4 w;
                    if (ACT == 2) { w.x = cvt_pk_bf16_c(v0[0], v0[1]); w.y = cvt_pk_bf16_c(v0[2], v0[3]); w.z = cvt_pk_bf16_c(v1[0], v1[1]); w.w = cvt_pk_bf16_c(v1[2], v1[3]); }
                    else { w.x = cvt_pk_bf16(v0[0], v0[1]); w.y = cvt_pk_bf16(v0[2], v0[3]); w.z = cvt_pk_bf16(v1[0], v1[1]); w.w = cvt_pk_bf16(v1[2], v1[3]); }
                    *(PG8_GAS u32x4*)(rowp + bj * HALF) = w; } }
    }
};
typedef unsigned u32x2h __attribute__((ext_vector_type(2)));
struct EpiF8 {
    static constexpr bool PERM = true, AFTER_DRAIN = false, MID = false;
    unsigned char* O; int ldc; float s;
    __device__ __forceinline__ void operator()(const f32x4 (&acc)[2][2][4][2], const Unit& u, int wr, int wc, int fr, int fq) const {
        const int row0 = u.pm * BM + wr * 64 + fr, col0 = u.pn * BM + wc * 32 + 8 * fq;
#pragma unroll
        for (int ai = 0; ai < 2; ++ai)
#pragma unroll
            for (int m = 0; m < 4; ++m) { unsigned char* rowp = O + (size_t)(row0 + ai * HALF + m * 16) * ldc + col0;
#pragma unroll
                for (int bj = 0; bj < 2; ++bj) { const f32x4 v0 = acc[ai][bj][m][0] * s, v1 = acc[ai][bj][m][1] * s;
                    int p0 = __builtin_amdgcn_cvt_pk_fp8_f32(sat8(v0[0]), sat8(v0[1]), 0, false); p0 = __builtin_amdgcn_cvt_pk_fp8_f32(sat8(v0[2]), sat8(v0[3]), p0, true);
                    int p1 = __builtin_amdgcn_cvt_pk_fp8_f32(sat8(v1[0]), sat8(v1[1]), 0, false); p1 = __builtin_amdgcn_cvt_pk_fp8_f32(sat8(v1[2]), sat8(v1[3]), p1, true);
                    u32x2h w; w.x = (unsigned)p0; w.y = (unsigned)p1; *(PG8_GAS u32x2h*)(rowp + bj * HALF) = w; } }
    }
};

__device__ __forceinline__ float bf_lo(unsigned w) { return __uint_as_float(w << 16); }
__device__ __forceinline__ float bf_hi(unsigned w) { return __uint_as_float(w & 0xffff0000u); }
__device__ __forceinline__ float sigmoidf_(float x) { return __builtin_amdgcn_rcpf(1.0f + __builtin_amdgcn_exp2f(-1.4426950408889634f * x)); }
__device__ __forceinline__ float gelu_tanh(float x) { const float u = x * (1.5957691216057308f + 0.07135481627f * x * x); return x * sigmoidf_(u); }

struct EpiE {
    static constexpr bool PERM = false, AFTER_DRAIN = false, MID = false;
    float* C;
    __device__ __forceinline__ void operator()(const f32x4 (&acc)[2][2][4][2], const Unit& u, int wr, int wc, int fr, int fq) const {
        const int row0 = u.pm * BM + wr * 64 + fr, col0 = wc * 32 + 4 * fq;
#pragma unroll
        for (int ai = 0; ai < 2; ++ai)
#pragma unroll
            for (int m = 0; m < 4; ++m) { float* rowp = C + (size_t)(row0 + ai * HALF + m * 16) * 128 + col0;
#pragma unroll
                for (int n = 0; n < 2; ++n) *(PG8_GAS f32x4*)(rowp + n * 16) = acc[ai][0][m][n]; }
    }
};
struct EpiS5Y {
    static constexpr bool PERM = true, AFTER_DRAIN = false, MID = false;
    bf16_t* ZS;
    __device__ __forceinline__ void operator()(const f32x4 (&acc)[2][2][4][2], const Unit& u, int wr, int wc, int fr, int fq) const {
        int pm_ = u.pm, pn_ = u.pn, fr_ = fr, fq_ = fq; asm volatile("" : "+s"(pm_), "+s"(pn_), "+v"(fr_), "+v"(fq_));
        const int g = pm_ >> 2, i = pm_ & 3, j = pn_ & 3;
        bf16_t* base = ZS + ((size_t)(256 * i + 64 * wr + fr_) * 64 + (16 * j + 2 * wc + (fq_ >> 1))) * 256 + 16 * g + 8 * (fq_ & 1);
#pragma unroll
        for (int ai = 0; ai < 2; ++ai)
#pragma unroll
            for (int m = 0; m < 4; ++m) {
#pragma unroll
                for (int bj = 0; bj < 2; ++bj) {
                    const f32x4 v0 = acc[ai][bj][m][0], v1 = acc[ai][bj][m][1];
                    u32x4 w; w.x = cvt_pk_bf16(gelu_tanh(v0[0]), gelu_tanh(v0[1])); w.y = cvt_pk_bf16(gelu_tanh(v0[2]), gelu_tanh(v0[3]));
                    w.z = cvt_pk_bf16(gelu_tanh(v1[0]), gelu_tanh(v1[1])); w.w = cvt_pk_bf16(gelu_tanh(v1[2]), gelu_tanh(v1[3]));
                    *(PG8_GAS u32x4*)(base + (size_t)((ai * HALF + m * 16) * 64 + bj * 8) * 256) = w; }
                asm volatile("" ::: "memory"); }
    }
};
typedef unsigned u32x2g __attribute__((ext_vector_type(2)));
struct EpiGlu {
    static constexpr bool PERM = true, AFTER_DRAIN = false, MID = false;
    const bf16_t* Zin; bf16_t* O; const float* bias; int ldo;
    __device__ __forceinline__ void operator()(const f32x4 (&acc)[2][2][4][2], const Unit& u, int wr, int wc, int fr, int fq) const {
        const int row0 = u.pm * BM + wr * 64 + fr, col0 = u.pn * BM + wc * 32 + 8 * fq;
#pragma unroll
        for (int bj = 0; bj < 2; ++bj) { const f32x4 b0 = *(const PG8_GAS f32x4*)(bias + col0 + bj * HALF), b1 = *(const PG8_GAS f32x4*)(bias + col0 + bj * HALF + 4);
#pragma unroll
            for (int ai = 0; ai < 2; ++ai)
#pragma unroll
                for (int m = 0; m < 4; ++m) { const size_t off = (size_t)(row0 + ai * HALF + m * 16) * 256 + col0 + bj * HALF;
                    const u32x4 z = *(const PG8_GAS u32x4*)(Zin + off); const f32x4 v0 = acc[ai][bj][m][0] + b0, v1 = acc[ai][bj][m][1] + b1;
                    u32x4 w; w.x = cvt_pk_bf16(bf_lo(z.x) * sigmoidf_(v0[0]), bf_hi(z.x) * sigmoidf_(v0[1])); w.y = cvt_pk_bf16(bf_lo(z.y) * sigmoidf_(v0[2]), bf_hi(z.y) * sigmoidf_(v0[3]));
                    w.z = cvt_pk_bf16(bf_lo(z.z) * sigmoidf_(v1[0]), bf_hi(z.z) * sigmoidf_(v1[1])); w.w = cvt_pk_bf16(bf_lo(z.w) * sigmoidf_(v1[2]), bf_hi(z.w) * sigmoidf_(v1[3]));
                    if (MERGE_FP8) { const float f[8] = {bf_lo(z.x) * sigmoidf_(v0[0]) * Y8_SCALE, bf_hi(z.x) * sigmoidf_(v0[1]) * Y8_SCALE, bf_lo(z.y) * sigmoidf_(v0[2]) * Y8_SCALE, bf_hi(z.y) * sigmoidf_(v0[3]) * Y8_SCALE,
                                                      bf_lo(z.z) * sigmoidf_(v1[0]) * Y8_SCALE, bf_hi(z.z) * sigmoidf_(v1[1]) * Y8_SCALE, bf_lo(z.w) * sigmoidf_(v1[2]) * Y8_SCALE, bf_hi(z.w) * sigmoidf_(v1[3]) * Y8_SCALE};
                        int p0 = __builtin_amdgcn_cvt_pk_fp8_f32(sat8(f[0]), sat8(f[1]), 0, false); p0 = __builtin_amdgcn_cvt_pk_fp8_f32(sat8(f[2]), sat8(f[3]), p0, true); int p1 = __builtin_amdgcn_cvt_pk_fp8_f32(sat8(f[4]), sat8(f[5]), 0, false); p1 = __builtin_amdgcn_cvt_pk_fp8_f32(sat8(f[6]), sat8(f[7]), p1, true);
                        u32x2g w8; w8.x = (unsigned)p0; w8.y = (unsigned)p1; *(PG8_GAS u32x2g*)((unsigned char*)O + (size_t)(row0 + ai * HALF + m * 16) * ldo + col0 + bj * HALF) = w8; }
                    else *(PG8_GAS u32x4*)(O + (size_t)(row0 + ai * HALF + m * 16) * ldo + col0 + bj * HALF) = w; } }
    }
};
struct EpiGates {
    static constexpr bool PERM = true, AFTER_DRAIN = false, MID = false;
    bf16_t* G; size_t gstride; float sc;
    __device__ __forceinline__ void operator()(const f32x4 (&acc)[2][2][4][2], const Unit& u, int wr, int wc, int fr, int fq) const {
        int pm_ = u.pm, pn_ = u.pn; asm volatile("" : "+s"(pm_), "+s"(pn_));
        const int row0 = pm_ * BM + wr * 64 + fr; const float ksc = -1.4426950408889634f * sc;
        if (pn_ < 8) { const int d0 = pn_ * 128 + wc * 32 + 8 * fq;
#pragma unroll
            for (int ai = 0; ai < 2; ++ai)
#pragma unroll
                for (int m = 0; m < 4; ++m) { const size_t off = (size_t)(row0 + ai * HALF + m * 16) * 1024 + d0;
                    float mv[8], ev[8];
#pragma unroll
                    for (int q = 0; q < 8; ++q) { const float z0 = acc[ai][0][m][q >> 2][q & 3] * ksc, z1 = acc[ai][1][m][q >> 2][q & 3] * ksc;
                        const float e0 = __builtin_amdgcn_exp2f(__builtin_amdgcn_fmed3f(z0, -43.28f, 43.28f)), e1 = __builtin_amdgcn_exp2f(__builtin_amdgcn_fmed3f(z1, -43.28f, 43.28f));
                        ev[q] = 1.0f + e1; mv[q] = (1.0f + e0) * __builtin_amdgcn_rcpf(1.0f + e1); }
                    u32x4 wm, we; wm.x = cvt_pk_bf16_c(mv[0], mv[1]); wm.y = cvt_pk_bf16_c(mv[2], mv[3]); wm.z = cvt_pk_bf16_c(mv[4], mv[5]); wm.w = cvt_pk_bf16_c(mv[6], mv[7]);
                    we.x = cvt_pk_bf16_c(ev[0], ev[1]); we.y = cvt_pk_bf16_c(ev[2], ev[3]); we.z = cvt_pk_bf16_c(ev[4], ev[5]); we.w = cvt_pk_bf16_c(ev[6], ev[7]);
                    *(PG8_GAS u32x4*)(G + off) = wm; *(PG8_GAS u32x4*)(G + gstride + off) = we; }
        } else { const bool plain = pn_ >= 12; bf16_t* base = plain ? G + 3 * gstride + 512 + (pn_ - 12) * BM : G + 2 * gstride + (pn_ - 8) * BM;
            const int c0 = wc * 32 + 8 * fq;
#pragma unroll
            for (int ai = 0; ai < 2; ++ai)
#pragma unroll
                for (int m = 0; m < 4; ++m)
#pragma unroll
                    for (int bj = 0; bj < 2; ++bj) { float v[8];
#pragma unroll
                        for (int q = 0; q < 8; ++q) { v[q] = acc[ai][bj][m][q >> 2][q & 3] * (plain ? sc : ksc); if (!plain) v[q] = 1.0f + __builtin_amdgcn_exp2f(__builtin_amdgcn_fmed3f(v[q], -43.28f, 43.28f)); }
                        u32x4 w; w.x = cvt_pk_bf16_c(v[0], v[1]); w.y = cvt_pk_bf16_c(v[2], v[3]); w.z = cvt_pk_bf16_c(v[4], v[5]); w.w = cvt_pk_bf16_c(v[6], v[7]);
                        *(PG8_GAS u32x4*)(base + (size_t)(row0 + ai * HALF + m * 16) * 1024 + c0 + bj * HALF) = w; }
        }
    }
};
typedef unsigned u32x2m __attribute__((ext_vector_type(2)));
#define SIGE(Q) __builtin_amdgcn_rcpf(Q)
struct EpiMerge {
    static constexpr bool PERM = true, AFTER_DRAIN = false, MID = true;
    static constexpr int T0 = MERGE_FP8 ? 4 : 8, T1 = MERGE_FP8 ? 6 : 12;
    const bf16_t* G; bf16_t* O; size_t gstride; float osc; const bf16_t* Z;
    __device__ __forceinline__ void mid(f32x4 (&acc)[2][2][4][2], const Unit& u, int wr, int wc, int fr, int fq, int t) const {
        const int row0 = u.pm * BM + wr * 64 + fr, col0 = u.pn * BM + wc * 32 + 8 * fq;
        const bf16_t* Ga = G + (t == T0 ? 0 : gstride); const bf16_t* Gb = Ga + gstride;
        const bool direct = PAIR_GATES && t == T0;
        u32x4 ga[2][2], gb[2][2];
#pragma unroll
        for (int bj = 0; bj < 2; ++bj) { const size_t off = (size_t)row0 * 1024 + col0 + bj * HALF; ga[0][bj] = *(const PG8_GAS u32x4*)(Ga + off); gb[0][bj] = *(const PG8_GAS u32x4*)(direct ? Z : Gb + off); }
#pragma unroll
        for (int g = 0; g < 8; ++g) { const int ai = g >> 2, m = g & 3, cb = g & 1, nb = cb ^ 1;
            if (g < 7) { const int ai1 = (g + 1) >> 2, m1 = (g + 1) & 3;
#pragma unroll
                for (int bj = 0; bj < 2; ++bj) { const size_t off = (size_t)(row0 + ai1 * HALF + m1 * 16) * 1024 + col0 + bj * HALF; ga[nb][bj] = *(const PG8_GAS u32x4*)(Ga + off); gb[nb][bj] = *(const PG8_GAS u32x4*)(direct ? Z : Gb + off); } }
            asm volatile("" ::: "memory");
#pragma unroll
            for (int bj = 0; bj < 2; ++bj) { const u32x4 xa = ga[cb][bj], xb = gb[cb][bj];
                const float a[8] = {bf_lo(xa.x), bf_hi(xa.x), bf_lo(xa.y), bf_hi(xa.y), bf_lo(xa.z), bf_hi(xa.z), bf_lo(xa.w), bf_hi(xa.w)};
                const float b[8] = {bf_lo(xb.x), bf_hi(xb.x), bf_lo(xb.y), bf_hi(xb.y), bf_lo(xb.z), bf_hi(xb.z), bf_lo(xb.w), bf_hi(xb.w)};
#pragma unroll
                for (int e = 0; e < 8; ++e) { const float ra = b[e] * __builtin_amdgcn_rcpf(a[e]);
                    acc[ai][bj][m][e >> 2][e & 3] *= ra; } }
            asm volatile("" ::: "memory"); }
    }
    __device__ __forceinline__ void operator()(const f32x4 (&acc)[2][2][4][2], const Unit& u, int wr, int wc, int fr, int fq) const {
        const bf16_t* G2 = G + 2 * gstride;
        const int row0 = u.pm * BM + wr * 64 + fr, col0 = u.pn * BM + wc * 32 + 8 * fq;
        u32x4 gq[2][2];
#pragma unroll
        for (int bj = 0; bj < 2; ++bj) gq[0][bj] = *(const PG8_GAS u32x4*)(G2 + (size_t)row0 * 1024 + col0 + bj * HALF);
#pragma unroll
        for (int g = 0; g < 8; ++g) { const int ai = g >> 2, m = g & 3, cb = g & 1, nb = cb ^ 1;
            if (g < 7) { const int ai1 = (g + 1) >> 2, m1 = (g + 1) & 3;
#pragma unroll
                for (int bj = 0; bj < 2; ++bj) gq[nb][bj] = *(const PG8_GAS u32x4*)(G2 + (size_t)(row0 + ai1 * HALF + m1 * 16) * 1024 + col0 + bj * HALF); }
            asm volatile("" ::: "memory");
#pragma unroll
            for (int bj = 0; bj < 2; ++bj) { const size_t off = (size_t)(row0 + ai * HALF + m * 16) * 1024 + col0 + bj * HALF;
                const u32x4 gl = gq[cb][bj]; const f32x4 v0 = acc[ai][bj][m][0] * osc, v1 = acc[ai][bj][m][1] * osc;
                if (OUT_FP8) { const float f[8] = {SIGE(bf_lo(gl.x)) * v0[0], SIGE(bf_hi(gl.x)) * v0[1], SIGE(bf_lo(gl.y)) * v0[2], SIGE(bf_hi(gl.y)) * v0[3], SIGE(bf_lo(gl.z)) * v1[0], SIGE(bf_hi(gl.z)) * v1[1], SIGE(bf_lo(gl.w)) * v1[2], SIGE(bf_hi(gl.w)) * v1[3]};
                    int p0 = __builtin_amdgcn_cvt_pk_fp8_f32(sat8(f[0]), sat8(f[1]), 0, false); p0 = __builtin_amdgcn_cvt_pk_fp8_f32(sat8(f[2]), sat8(f[3]), p0, true); int p1 = __builtin_amdgcn_cvt_pk_fp8_f32(sat8(f[4]), sat8(f[5]), 0, false); p1 = __builtin_amdgcn_cvt_pk_fp8_f32(sat8(f[6]), sat8(f[7]), p1, true);
                    u32x2m w8; w8.x = (unsigned)p0; w8.y = (unsigned)p1; *(PG8_GAS u32x2m*)((unsigned char*)O + off) = w8; }
                else {
                u32x4 w; w.x = cvt_pk_bf16(SIGE(bf_lo(gl.x)) * v0[0], SIGE(bf_hi(gl.x)) * v0[1]); w.y = cvt_pk_bf16(SIGE(bf_lo(gl.y)) * v0[2], SIGE(bf_hi(gl.y)) * v0[3]);
                w.z = cvt_pk_bf16(SIGE(bf_lo(gl.z)) * v1[0], SIGE(bf_hi(gl.z)) * v1[1]); w.w = cvt_pk_bf16(SIGE(bf_lo(gl.w)) * v1[2], SIGE(bf_hi(gl.w)) * v1[3]);
                *(PG8_GAS u32x4*)(O + off) = w; } }
            asm volatile("" ::: "memory"); }
    }
};
__device__ __forceinline__ float dpp_shr1(float v) { return __int_as_float(__builtin_amdgcn_update_dpp(0, __float_as_int(v), 0x111, 0xf, 0xf, true)); }
typedef unsigned u32x2e __attribute__((ext_vector_type(2)));
struct EpiConv {
    static constexpr bool PERM = true, AFTER_DRAIN = false, MID = false;
    const float* cw; const float* cb; bf16_t* A2; float* HALO; float usc;
    __device__ __forceinline__ void operator()(const f32x4 (&acc)[2][2][4][2], const Unit& u, int wr, int wc, int fr, int fq) const {
        int pm_ = u.pm, pn_ = u.pn; asm volatile("" : "+s"(pm_), "+s"(pn_));
        const int j0 = pn_ * 128 + wc * 32 + 8 * fq, tok0 = pm_ * BM + wr * 128 + fr * 8;
        float* hb = HALO + (size_t)(pm_ * 2 + wr) * 4 * 4096 + j0;
        if (fr == 0) {
#pragma unroll
            for (int bj = 0; bj < 2; ++bj)
#pragma unroll
                for (int n = 0; n < 2; ++n) { *(PG8_GAS f32x4*)(hb + 0 * 4096 + bj * 2048 + 4 * n) = acc[0][bj][0][n]; *(PG8_GAS f32x4*)(hb + 1 * 4096 + bj * 2048 + 4 * n) = acc[0][bj][1][n]; } }
        if (fr == 15) {
#pragma unroll
            for (int bj = 0; bj < 2; ++bj)
#pragma unroll
                for (int n = 0; n < 2; ++n) { *(PG8_GAS f32x4*)(hb + 2 * 4096 + bj * 2048 + 4 * n) = acc[1][bj][2][n]; *(PG8_GAS f32x4*)(hb + 3 * 4096 + bj * 2048 + 4 * n) = acc[1][bj][3][n]; } }
        unsigned pk[8][4];
#pragma unroll
        for (int n = 0; n < 2; ++n) {
            f32x4 w0g = *(const PG8_GAS f32x4*)(cw + j0 + 4 * n), w1g = *(const PG8_GAS f32x4*)(cw + 4096 + j0 + 4 * n), w2g = *(const PG8_GAS f32x4*)(cw + 8192 + j0 + 4 * n); const f32x4 bg = *(const PG8_GAS f32x4*)(cb + j0 + 4 * n);
            f32x4 w0v = *(const PG8_GAS f32x4*)(cw + 2048 + j0 + 4 * n), w1v = *(const PG8_GAS f32x4*)(cw + 4096 + 2048 + j0 + 4 * n), w2v = *(const PG8_GAS f32x4*)(cw + 8192 + 2048 + j0 + 4 * n); const f32x4 bv = *(const PG8_GAS f32x4*)(cb + 2048 + j0 + 4 * n);
            if (UP_FP8) { w0g = w0g * usc; w1g = w1g * usc; w2g = w2g * usc; w0v = w0v * usc; w1v = w1v * usc; w2v = w2v * usc; }
#pragma unroll
            for (int i2 = 0; i2 < 2; ++i2) {
                float outp[2][8];
#pragma unroll
                for (int ii = 0; ii < 2; ++ii) { const int i = 2 * i2 + ii;
                    float G[8], V[8];
#pragma unroll
                    for (int e = 0; e < 8; ++e) { G[e] = acc[e >> 2][0][e & 3][n][i]; V[e] = acc[e >> 2][1][e & 3][n][i]; }
                    const float gm1 = dpp_shr1(G[7]), gm2 = dpp_shr1(G[6]), vm1 = dpp_shr1(V[7]), vm2 = dpp_shr1(V[6]);
#pragma unroll
                    for (int e = 0; e < 8; ++e) {
                        const float ga = (e >= 2) ? G[e >= 2 ? e - 2 : 0] : (e == 0 ? gm2 : gm1), gb = (e >= 1) ? G[e >= 1 ? e - 1 : 0] : gm1;
                        const float va = (e >= 2) ? V[e >= 2 ? e - 2 : 0] : (e == 0 ? vm2 : vm1), vb = (e >= 1) ? V[e >= 1 ? e - 1 : 0] : vm1;
                        const float cg = bg[i] + w0g[i] * ga + w1g[i] * gb + w2g[i] * G[e], cv = bv[i] + w0v[i] * va + w1v[i] * vb + w2v[i] * V[e];
                        outp[ii][e] = gelu_tanh(cg) * cv; } }
#pragma unroll
                for (int e = 0; e < 8; ++e) { if (DOWN_FP8) { if (i2 == 0) pk[e][n] = (unsigned)__builtin_amdgcn_cvt_pk_fp8_f32(sat8(outp[0][e]), sat8(outp[1][e]), 0, false); else pk[e][n] = (unsigned)__builtin_amdgcn_cvt_pk_fp8_f32(sat8(outp[0][e]), sat8(outp[1][e]), (int)pk[e][n], true); }
                    else pk[e][2 * n + i2] = cvt_pk_bf16(outp[0][e], outp[1][e]); }
            }
        }
#pragma unroll
        for (int e = 0; e < 8; ++e) { if (DOWN_FP8) { u32x2e w; w.x = pk[e][0]; w.y = pk[e][1]; *(PG8_GAS u32x2e*)((unsigned char*)A2 + (size_t)(tok0 + e) * 2048 + j0) = w; }
            else { u32x4 w; w.x = pk[e][0]; w.y = pk[e][1]; w.z = pk[e][2]; w.w = pk[e][3]; *(PG8_GAS u32x4*)(A2 + (size_t)(tok0 + e) * 2048 + j0) = w; } }
    }
};
struct PanelOrder {
    int pm, n, rot = 0;
    __device__ __forceinline__ bool next(int i, Unit& u) const { if (i >= n) return false; int p = pm; asm volatile("" : "+s"(p)); u.pm = p; u.pn = (i + rot) & (n - 1); return true; }
    __device__ __forceinline__ void a_ready(const Unit&) const {}
    __device__ __forceinline__ void done(const Unit&) const {}
};
struct QQOrder {
    int G, c;
    __device__ __forceinline__ bool next(int i, Unit& u) const {
        if (G != 256) { const int L = i * G + c; if (L >= 1280) return false; u.pm = L / 5; u.pn = L % 5; return true; }
        int L; if (c >= 64) { if (i >= 6) return false; L = (c - 64) * 6 + i; } else { if (i >= 2) return false; L = 1152 + c * 2 + i; }
        u.pm = L / 5; u.pn = L % 5; return true; }
    __device__ __forceinline__ void a_ready(const Unit&) const {}
    __device__ __forceinline__ void done(const Unit&) const {}
};
template <int NJ> struct GroupOrder {
    int G, c;
    __device__ __forceinline__ bool next(int i, Unit& u) const { const int L = i * G + c; if (L >= 16 * 4 * NJ) return false; const int g = L / (4 * NJ), r = L % (4 * NJ); u.pm = 4 * g + r / NJ; u.pn = NJ * g + r % NJ; return true; }
    __device__ __forceinline__ void a_ready(const Unit&) const {}
    __device__ __forceinline__ void done(const Unit&) const {}
};
template <class Epi, class Sched, bool ALIGN_EPI = false, bool SP2 = false, bool FP8 = false>
__device__ __forceinline__ void gemm_phase(PG8_LAS unsigned char* lds, const Gemm g, const Sched& S, const Epi& E, const int wave_in) {
    int lane_; asm volatile("v_mbcnt_lo_u32_b32 %0, -1, 0\n\tv_mbcnt_hi_u32_b32 %0, -1, %0" : "=v"(lane_));
    const int wid = wave_in, lane = lane_, tid = wid * 64 + lane, wr = wid >> 2, wc = wid & 3, fr = lane & 15, fq = lane >> 4;
    const int K = g.K, nt = K / BK, lda = g.lda, ldb = g.ldb;
    unsigned voffA[2], voffB[2];
#pragma unroll
    for (int i = 0; i < 2; ++i) { int R, C; stage_rc(tid * 16 + i * 8192, R, C); const int Rb = Epi::PERM ? ((R & ~31) + perm32(R & 31)) : R;
        voffA[i] = (unsigned)(R * lda + C) * 2u; voffB[i] = (unsigned)(Rb * ldb + C) * 2u; }
    const size_t kstep = (size_t)(BK * 2);
    const size_t hstepA = (size_t)HALF * lda * 2, hstepB = (size_t)HALF * ldb * 2;
    const size_t tstepA = 2 * hstepA, tstepB = 2 * hstepB;
    const unsigned ldsw = (unsigned)wid * 1024u;
    const int aoff = lds_byte(wr * 64 + fr, fq * 8), boff = lds_byte(wc * 32 + fr, fq * 8);
#define PG8_SA(b, h) (((b) * 2 + (h)) * HTB)
#define PG8_SB(b, h) ((4 + (b) * 2 + (h)) * HTB)
#define PG8_STAGE(bufoff, gbase, voff) do { _Pragma("unroll") for (int _i = 0; _i < 2; ++_i) { unsigned _v = (voff)[_i]; asm volatile("" : "+v"(_v));     \
        __builtin_amdgcn_global_load_lds((const unsigned*)((const char*)(gbase) + _v), (PG8_LAS unsigned*)(lds + (bufoff) + ldsw + _i * 8192), 16, 0, 0); } } while (0)
#define PG8_LDA(dst, b, h) do { _Pragma("unroll") for (int m = 0; m < 4; ++m) _Pragma("unroll") for (int k = 0; k < 2; ++k) dst[m][k] = *(const PG8_LAS bf16x8*)(lds + PG8_SA(b, h) + aoff + m * 2048 + k * 1024); } while (0)
#define PG8_LDB(dst, b, h) do { _Pragma("unroll") for (int n = 0; n < 2; ++n) _Pragma("unroll") for (int k = 0; k < 2; ++k) dst[n][k] = *(const PG8_LAS bf16x8*)(lds + PG8_SB(b, h) + boff + n * 2048 + k * 1024); } while (0)
#define PG8_MMA(ai, bj, At, Bt) do { __builtin_amdgcn_s_setprio(1); _Pragma("unroll") for (int m = 0; m < 4; ++m) _Pragma("unroll") for (int n = 0; n < 2; ++n) { \
        if constexpr (FP8) acc[ai][bj][m][n] = __builtin_amdgcn_mfma_scale_f32_16x16x128_f8f6f4(cat8(Bt[n][0], Bt[n][1]), cat8(At[m][0], At[m][1]), acc[ai][bj][m][n], 0, 0, 0, 0, 0, 0); \
        else { _Pragma("unroll") for (int k = 0; k < 2; ++k) acc[ai][bj][m][n] = __builtin_amdgcn_mfma_f32_16x16x32_bf16(Bt[n][k], At[m][k], acc[ai][bj][m][n], 0, 0, 0); } } __builtin_amdgcn_s_setprio(0); } while (0)
#define PG8_WAIT_V(n) asm volatile("s_waitcnt vmcnt(" #n ")" ::: "memory")
#define PG8_WAIT_L(n) asm volatile("s_waitcnt lgkmcnt(" #n ")" ::: "memory")
#define PG8_BAR __builtin_amdgcn_s_barrier()
#define PG8_SCHED __builtin_amdgcn_sched_barrier(0)
    Unit cur, nxt; int ui = 0;
    if (!S.next(0, cur)) return;
    f32x4 acc[2][2][4][2];
#pragma unroll
    for (int a = 0; a < 2; ++a)
#pragma unroll
        for (int b = 0; b < 2; ++b)
#pragma unroll
            for (int m = 0; m < 4; ++m)
#pragma unroll
                for (int n = 0; n < 2; ++n) acc[a][b][m][n] = (f32x4){0.f, 0.f, 0.f, 0.f};
    bf16x8 At[4][2], B0[2][2], B1[2][2];
    const char* cA = (const char*)g.A + (size_t)cur.pm * tstepA; const char* cB = (const char*)g.Bt + (size_t)cur.pn * tstepB;
    S.a_ready(cur);
    if constexpr (SP2) {
        PG8_STAGE(PG8_SB(0, 0), cB, voffB); PG8_STAGE(PG8_SB(0, 1), cB + hstepB, voffB); PG8_STAGE(PG8_SA(0, 0), cA, voffA); PG8_STAGE(PG8_SA(0, 1), cA + hstepA, voffA);
        if (wr == 1) PG8_BAR;
        PG8_WAIT_V(2); PG8_BAR;
        PG8_STAGE(PG8_SB(1, 0), cB + kstep, voffB); PG8_STAGE(PG8_SA(1, 0), cA + kstep, voffA); PG8_STAGE(PG8_SB(1, 1), cB + hstepB + kstep, voffB);
        PG8_WAIT_V(6); PG8_BAR;
    } else {
        PG8_STAGE(PG8_SB(0, 0), cB, voffB); PG8_STAGE(PG8_SA(0, 0), cA, voffA); PG8_STAGE(PG8_SB(0, 1), cB + hstepB, voffB); PG8_STAGE(PG8_SA(0, 1), cA + hstepA, voffA);
        if (wr == 1) PG8_BAR;
        PG8_WAIT_V(4); PG8_BAR;
        PG8_STAGE(PG8_SB(1, 0), cB + kstep, voffB); PG8_STAGE(PG8_SA(1, 0), cA + kstep, voffA); PG8_STAGE(PG8_SB(1, 1), cB + hstepB + kstep, voffB);
        PG8_WAIT_V(6); PG8_BAR;
    }
    for (;;) {
        const bool has_next = S.next(ui + 1, nxt);
        const char* nA = has_next ? (const char*)g.A + (size_t)nxt.pm * tstepA : cA; const char* nB = has_next ? (const char*)g.Bt + (size_t)nxt.pn * tstepB : cB;
#pragma nounroll
        for (int t = 0; t < nt; t += 2) {
            const bool last = (t == nt - 2);
            const char* a1 = cA + (size_t)(t + 1) * kstep;
            const char* a2 = last ? nA : cA + (size_t)(t + 2) * kstep; const char* b2 = last ? nB : cB + (size_t)(t + 2) * kstep;
            const char* a3 = a2 + kstep; const char* b3 = b2 + kstep;
            if (last && has_next) S.a_ready(nxt);
            if constexpr (Epi::MID) { if (t == Epi::T0 || t == Epi::T1) { int lm_; asm volatile("v_mbcnt_lo_u32_b32 %0, -1, 0\n\tv_mbcnt_hi_u32_b32 %0, -1, %0" : "=v"(lm_)); if constexpr (ALIGN_EPI) { if (wr == 0) PG8_BAR; }     E.mid(acc, cur, wr, wc, lm_ & 15, lm_ >> 4, t); if constexpr (ALIGN_EPI) { if (wr == 1) PG8_BAR; } } }
            if constexpr (SP2) {
            PG8_LDB(B0, 0, 0); PG8_LDB(B1, 0, 1); PG8_SCHED; PG8_LDA(At, 0, 0); PG8_STAGE(PG8_SA(1, 1), a1 + hstepA, voffA);
            PG8_WAIT_V(8); PG8_WAIT_L(0); PG8_BAR; PG8_MMA(0, 0, At, B0); PG8_MMA(0, 1, At, B1); PG8_BAR; PG8_SCHED;
            PG8_LDA(At, 0, 1); PG8_STAGE(PG8_SB(0, 0), b2, voffB); PG8_STAGE(PG8_SB(0, 1), b2 + hstepB, voffB); PG8_STAGE(PG8_SA(0, 0), a2, voffA);
            PG8_WAIT_V(8); PG8_WAIT_L(0); PG8_BAR; PG8_MMA(1, 0, At, B0); PG8_MMA(1, 1, At, B1); PG8_BAR; PG8_SCHED;
            PG8_LDB(B0, 1, 0); PG8_LDB(B1, 1, 1); PG8_SCHED; PG8_LDA(At, 1, 0); PG8_STAGE(PG8_SA(0, 1), a2 + hstepA, voffA);
            PG8_WAIT_V(8); PG8_WAIT_L(0); PG8_BAR; PG8_MMA(0, 0, At, B0); PG8_MMA(0, 1, At, B1); PG8_BAR; PG8_SCHED;
            PG8_LDA(At, 1, 1); PG8_STAGE(PG8_SB(1, 0), b3, voffB); PG8_STAGE(PG8_SB(1, 1), b3 + hstepB, voffB); PG8_STAGE(PG8_SA(1, 0), a3, voffA);
            PG8_WAIT_V(8); PG8_WAIT_L(0); PG8_BAR; PG8_MMA(1, 0, At, B0); PG8_MMA(1, 1, At, B1); PG8_BAR; PG8_SCHED;
            } else {
            PG8_LDB(B0, 0, 0); PG8_SCHED; PG8_LDA(At, 0, 0); PG8_STAGE(PG8_SA(1, 1), a1 + hstepA, voffA);
            PG8_WAIT_L(8); PG8_BAR; PG8_WAIT_L(0); PG8_MMA(0, 0, At, B0); PG8_BAR; PG8_SCHED;
            PG8_LDB(B1, 0, 1); PG8_STAGE(PG8_SB(0, 0), b2, voffB);
            PG8_BAR; PG8_WAIT_L(0); PG8_MMA(0, 1, At, B1); PG8_BAR;
            PG8_LDA(At, 0, 1); PG8_STAGE(PG8_SA(0, 0), a2, voffA);
            PG8_BAR; PG8_WAIT_L(0); PG8_MMA(1, 0, At, B0); PG8_BAR; PG8_SCHED;
            PG8_STAGE(PG8_SB(0, 1), b2 + hstepB, voffB);
            PG8_WAIT_V(6); PG8_BAR; PG8_MMA(1, 1, At, B1); PG8_BAR;
            PG8_LDB(B0, 1, 0); PG8_SCHED; PG8_LDA(At, 1, 0); PG8_STAGE(PG8_SA(0, 1), a2 + hstepA, voffA);
            PG8_WAIT_L(8); PG8_BAR; PG8_WAIT_L(0); PG8_MMA(0, 0, At, B0); PG8_BAR; PG8_SCHED;
            PG8_LDB(B1, 1, 1); PG8_STAGE(PG8_SB(1, 0), b3, voffB);
            PG8_BAR; PG8_WAIT_L(0); PG8_MMA(0, 1, At, B1); PG8_BAR;
            PG8_LDA(At, 1, 1); PG8_STAGE(PG8_SA(1, 0), a3, voffA);
            PG8_BAR; PG8_WAIT_L(0); PG8_MMA(1, 0, At, B0); PG8_BAR; PG8_SCHED;
            PG8_STAGE(PG8_SB(1, 1), b3 + hstepB, voffB);
            PG8_WAIT_V(6); PG8_BAR; PG8_MMA(1, 1, At, B1); PG8_BAR;
            }
        }
        if constexpr (ALIGN_EPI) { if (wr == 0) PG8_BAR; }
        if constexpr (!Epi::AFTER_DRAIN) { int le_; asm volatile("v_mbcnt_lo_u32_b32 %0, -1, 0\n\tv_mbcnt_hi_u32_b32 %0, -1, %0" : "=v"(le_));
            E(acc, cur, wr, wc, le_ & 15, le_ >> 4); S.done(cur); }
        if (!has_next) break;
#pragma unroll
        for (int a = 0; a < 2; ++a)
#pragma unroll
            for (int b = 0; b < 2; ++b)
#pragma unroll
                for (int m = 0; m < 4; ++m)
#pragma unroll
                    for (int n = 0; n < 2; ++n) acc[a][b][m][n] = (f32x4){0.f, 0.f, 0.f, 0.f};
        cur = nxt; cA = nA; cB = nB; ++ui;
        if constexpr (ALIGN_EPI) { if (wr == 1) PG8_BAR; }
    }
    PG8_WAIT_V(0);
    if constexpr (!ALIGN_EPI) { if (wr == 0) PG8_BAR; }
    PG8_BAR;
    if constexpr (Epi::AFTER_DRAIN) { E.fused(acc, cur, wr, wc, fr, fq, lds, wid, lane); S.done(cur); }
#undef PG8_SA
#undef PG8_SB
#undef PG8_STAGE
#undef PG8_LDA
#undef PG8_LDB
#undef PG8_MMA
#undef PG8_WAIT_V
#undef PG8_WAIT_L
#undef PG8_BAR
#undef PG8_SCHED
}
}
#define GAS __attribute__((address_space(1)))
#define LAS __attribute__((address_space(3)))
typedef unsigned short bf16;
typedef unsigned v4u __attribute__((ext_vector_type(4)));
typedef float f32x4 __attribute__((ext_vector_type(4)));
typedef short bf16x8 __attribute__((ext_vector_type(8)));
typedef GAS unsigned gu32;
typedef GAS unsigned long long gu64;
#define RLX_AGENT __ATOMIC_RELAXED, __HIP_MEMORY_SCOPE_AGENT
#define LDS_WAIT() asm volatile("s_waitcnt lgkmcnt(0)" ::: "memory")
#define VM_WAIT() asm volatile("s_waitcnt vmcnt(0)" ::: "memory")
__device__ __forceinline__ unsigned long long rt() { return __builtin_amdgcn_s_memrealtime(); }
__device__ __forceinline__ unsigned f2bf(float f) { unsigned u = __builtin_bit_cast(unsigned, f); return (u + 0x7fffu + ((u >> 16) & 1u)) >> 16; }
__device__ __forceinline__ unsigned pk2(float lo, float hi) { return f2bf(lo) | (f2bf(hi) << 16); }

#define XB_TMO      128
#define XB_XCNT(j)  (256  + 64 * (j))
#define XB_XSUB(j)  (1280 + 64 * (j))
#define XB_XGEN(j)  (2304 + 64 * (j))
#define XB_TOP      3328
#define XB_TOPGEN   3392
#define XCD_BAR_WORDS 3456
#define XB_SPIN_CAP (1u << 18)

__device__ __forceinline__ unsigned xb_ld(unsigned* p)              { return __hip_atomic_load(p, __ATOMIC_RELAXED, __HIP_MEMORY_SCOPE_AGENT); }
__device__ __forceinline__ unsigned xb_add(unsigned* p, unsigned v) { return __hip_atomic_fetch_add(p, v, __ATOMIC_RELAXED, __HIP_MEMORY_SCOPE_AGENT); }
__device__ __forceinline__ unsigned xb_xcc_id() { return (unsigned)__builtin_amdgcn_s_getreg((3 << 11) | 20) & 0xFu; }
#define XB_SPIN(cond, bar) do { unsigned _sp = 0; while (cond) { __builtin_amdgcn_s_sleep(1); \
    if ((++_sp & 255u) == 0u) { if (xb_ld(&(bar)[XB_TMO])) break; if (_sp > XB_SPIN_CAP) { atomicAdd(&(bar)[XB_TMO], 1u); break; } } } } while (0)

__device__ __forceinline__ int xb_lane() { int l; asm volatile("v_mbcnt_lo_u32_b32 %0, -1, 0\n\tv_mbcnt_hi_u32_b32 %0, -1, %0" : "=v"(l)); return l; }
struct XcdBarrier {
    unsigned* bar; unsigned x; int wave;
    volatile LAS unsigned* st;
};

__device__ __forceinline__ XcdBarrier xcd_barrier_post(unsigned* bar, volatile LAS unsigned* st) {
    XcdBarrier b; b.bar = bar; b.x = xb_xcc_id(); b.st = st; b.wave = 0;
    if (threadIdx.x == 0) (void)xb_add(&bar[XB_XCNT(b.x)], 1u);
    return b;
}
__device__ __forceinline__ void xcd_barrier_complete(unsigned* bar, unsigned x, unsigned& nloc, unsigned& nx) {
    const unsigned G = gridDim.x * gridDim.y * gridDim.z;
    unsigned sum, cnt, mine, sp = 0u;
    for (;;) {
        sum = 0u; cnt = 0u; mine = 0u;
#pragma unroll
        for (unsigned j = 0; j < 16; ++j) { const unsigned c = xb_ld(&bar[XB_XCNT(j)]); sum += c; cnt += (c > 0u) ? 1u : 0u; mine = (j == x) ? c : mine; }
        if (sum == G) break;
        __builtin_amdgcn_s_sleep(1);
        if ((++sp & 255u) == 0u) { if (xb_ld(&bar[XB_TMO])) break; if (sp > XB_SPIN_CAP) { atomicAdd(&bar[XB_TMO], 1u); break; } }
    }
    nloc = mine > 0u ? mine : 1u; nx = cnt > 0u ? cnt : 1u;
}

__device__ __forceinline__ void xcd_barrier(const XcdBarrier& b) {
    asm volatile("s_waitcnt vmcnt(0)" ::: "memory");
    __syncthreads();
    if (b.wave == 0 && xb_lane() == 0) {
        unsigned* bar = b.bar; asm volatile("" : "+s"(bar));
        __builtin_amdgcn_s_waitcnt(0);
        unsigned nloc = b.st[0], nx = b.st[1];
        if (nloc == 0u) { xcd_barrier_complete(bar, b.x, nloc, nx); b.st[0] = nloc; b.st[1] = nx; }
        const unsigned old = xb_add(&bar[XB_XSUB(b.x)], 1u);
        const unsigned gen = old / nloc;
        if (old + 1u == (gen + 1u) * nloc) {
            __builtin_amdgcn_fence(__ATOMIC_RELEASE, "agent");
            asm volatile("s_waitcnt vmcnt(0)" ::: "memory");
            const unsigned og = xb_add(&bar[XB_TOP], 1u);
            const unsigned tg = og / nx;
            if (og + 1u == (tg + 1u) * nx) xb_add(&bar[XB_TOPGEN], 1u);
            else XB_SPIN(xb_ld(&bar[XB_TOPGEN]) == tg, bar);
            __builtin_amdgcn_fence(__ATOMIC_ACQUIRE, "agent");
            xb_add(&bar[XB_XGEN(b.x)], 1u);
            asm volatile("s_waitcnt vmcnt(0)" ::: "memory");
        } else {
            XB_SPIN(xb_ld(&bar[XB_XGEN(b.x)]) == gen, bar);
            __builtin_amdgcn_fence(__ATOMIC_ACQUIRE, "agent");
            asm volatile("s_waitcnt vmcnt(0)" ::: "memory");
        }
    }
    __syncthreads();
}

#define DI __device__ __forceinline__
constexpr int NWAVES = 8;
constexpr int BATCH = 32, SEQ = 2048, DM = 1024, MTOK = BATCH * SEQ, DEPTH = 2;
constexpr int NIN = 4008, DFF = 2048, NMOD = 6 * DM;
constexpr float RMS_EPS = 1e-6f;
constexpr size_t MiB = 1u << 20;
constexpr size_t WS_CTL = 0, CTL_ZERO_BYTES = 1 * MiB;
constexpr size_t WS_MOD = 1 * MiB;
constexpr size_t WS_LAMJ = 3 * MiB;
constexpr size_t WS_BBAR = 5 * MiB;
constexpr size_t WS_KT = 6 * MiB;
constexpr size_t WS_W = 8 * MiB, W_SLOT = 28 * MiB;
constexpr size_t W_IN = 0, W_UP = 8 * MiB, W_DOWN = 16 * MiB, W_M = 20 * MiB, W_OUT = 22 * MiB, W_Q = 24 * MiB, W_UVF = 25 * MiB, W_GLU = 26 * MiB, W_POOL = 26 * MiB + 128 * 1024;
constexpr size_t WS_WY = 64 * MiB;
constexpr size_t WS_WE = 100 * MiB;
constexpr size_t WS_ZG = 108 * MiB;
constexpr size_t WS_ZS = 492 * MiB;
constexpr size_t WS_YC = WS_ZS;
constexpr size_t WS_QQ = 620 * MiB;
constexpr size_t WS_MG = WS_QQ;
constexpr size_t WS_H8 = WS_QQ;
constexpr size_t WS_H = 780 * MiB;
constexpr size_t WS_CQN = 780 * MiB, WS_CKVN = 812 * MiB, WS_AS5 = 828 * MiB, WS_POOLED = 864 * MiB, WS_E = 896 * MiB, WS_KI = 904 * MiB;
constexpr size_t WS_SELQ = 908 * MiB, WS_ZSS = 924 * MiB, WS_YS = 956 * MiB, WS_YP = 988 * MiB, WS_WI = 1020 * MiB, WS_END = 1022 * MiB;
constexpr size_t WS_Y = 108 * MiB;
constexpr size_t WS_U = 108 * MiB;
constexpr size_t WS_HALO = 108 * MiB;
constexpr size_t WS_A2 = 140 * MiB;
constexpr size_t WS_Y2 = 400 * MiB;
constexpr int AS5_LD = 1152;
constexpr int CW_BAR = 4096;
constexpr int RING_OFF = 0, RING_BYTES = 131072, LDSCTL_OFF = RING_BYTES, MISC_OFF = LDSCTL_OFF + 320, LDS_BYTES = 147456;

enum { I_X = 0, I_C, I_MODW, I_MODB, I_MIXPRE, I_MIXPOST, I_FFNPRE, I_FFNPOST, I_WIN, I_GCQ, I_WUQ, I_WQI, I_GCKV, I_WUV, I_ARE, I_AIM, I_BRE, I_BIM, I_CRE, I_CIM,
       I_DSKIP, I_LOGSTEP, I_WGLU, I_BGLU, I_WPOOL, I_PSCALE, I_PA, I_PB, I_PC, I_WOUT, I_WUP, I_CONVW, I_CONVB, I_WDOWN, N_INPUTS };
struct Args { const float* in[N_INPUTS]; float* out; unsigned char* ws; int ph_lo, ph_hi, li, pad; };

typedef float f32x2v __attribute__((ext_vector_type(2)));
typedef unsigned u32x2v __attribute__((ext_vector_type(2)));
struct Frame {
    LAS unsigned char* lds;
    volatile LAS unsigned* MISC;
    gu32* ctl;
    int wave, vcu, G;
    unsigned char* ws;
    float* out;
};
DI unsigned char* wsl(unsigned char* p) { asm volatile("" : "+s"(p)); return p; }
DI int lane_id() { int l; asm volatile("v_mbcnt_lo_u32_b32 %0, -1, 0\n\tv_mbcnt_hi_u32_b32 %0, -1, %0" : "=v"(l)); return l; }
DI float wave_sum(float v, int) {
    v += __int_as_float(__builtin_amdgcn_update_dpp(0, __float_as_int(v), 0xB1, 0xf, 0xf, true));
    v += __int_as_float(__builtin_amdgcn_update_dpp(0, __float_as_int(v), 0x4E, 0xf, 0xf, true));
    v += __int_as_float(__builtin_amdgcn_update_dpp(0, __float_as_int(v), 0x141, 0xf, 0xf, true));
    v += __int_as_float(__builtin_amdgcn_update_dpp(0, __float_as_int(v), 0x140, 0xf, 0xf, true));
    v += __int_as_float(__builtin_amdgcn_ds_swizzle(__float_as_int(v), 0x401F));
    { auto rr = __builtin_amdgcn_permlane32_swap(__float_as_uint(v), __float_as_uint(v), false, false); v = __uint_as_float(rr[0]) + __uint_as_float(rr[1]); }
    return v;
}
DI unsigned cvtpk(float lo, float hi) { unsigned r; asm volatile("v_cvt_pk_bf16_f32 %0, %1, %2" : "=v"(r) : "v"(lo), "v"(hi)); return r; }
DI float bflo(unsigned w) { return __uint_as_float(w << 16); }
DI float bfhi(unsigned w) { return __uint_as_float(w & 0xffff0000u); }
DI float sigm(float x) { return __builtin_amdgcn_rcpf(1.0f + __builtin_amdgcn_exp2f(-1.4426950408889634f * x)); }
DI float gelu_t(float x) { const float u = x * (1.5957691216057308f + 0.07135481627f * x * x); return x * sigm(u); }
DI bf16* wslot(const Frame& F, int l, size_t off) { return (bf16*)(wsl(F.ws) + WS_W + (size_t)l * W_SLOT + off); }

template <int MAP> DI int srcmap(int nd) { if (MAP == 0) return nd; if (MAP == 2) { const int pn = nd >> 8, r = nd & 255; return r < 128 ? 128 * pn + r : 2048 + 128 * pn + (r - 128); }
    if (PAIR_GATES && nd < 2048) { const int j = nd >> 8, r = nd & 255; return 936 + (r < 128 ? 0 : 1024) + 128 * j + (r & 127); }
    return nd < 3072 ? 936 + nd : (nd - 3072 < 936 ? nd - 3072 : -1); }
template <int MAP> DI void p0_transpose_item(const float* W, int K, int Nsrc, int Ndst, bf16* WT, int ldk, int dst_row_off, LAS float* scr, int item, int lane, int dst_col_off = 0) {
    const int nblk = Ndst / 32, kb = item / nblk, nb = item % nblk, k0 = 64 * kb, n0 = 32 * nb;
    const int ns = srcmap<MAP>(n0 + (lane & 31));
#pragma unroll 8
    for (int i = 0; i < 32; ++i) { const int kk = 2 * i + (lane >> 5); scr[kk * 33 + (lane & 31)] = (ns >= 0) ? W[(size_t)(k0 + kk) * Nsrc + ns] : 0.f; }
    LDS_WAIT(); asm volatile("" ::: "memory");
    const int c = lane & 7;
#pragma unroll
    for (int j = 0; j < 4; ++j) { const int n = (lane >> 3) + 8 * j; const LAS float* s = scr + (8 * c) * 33 + n;
        v4u o; o.x = cvtpk(s[0 * 33], s[1 * 33]); o.y = cvtpk(s[2 * 33], s[3 * 33]); o.z = cvtpk(s[4 * 33], s[5 * 33]); o.w = cvtpk(s[6 * 33], s[7 * 33]);
        *(GAS v4u*)(WT + (size_t)(dst_row_off + n0 + n) * ldk + dst_col_off + k0 + 8 * c) = o; }
    LDS_WAIT(); asm volatile("" ::: "memory");
}
template <int MAP> DI void p0_transpose_item8(const float* W, int K, int Nsrc, int Ndst, unsigned char* WT, int ldk, LAS float* scr, int item, int lane, int dst_col_off = 0, int dst_row_off = 0) {
    const int nblk = Ndst / 32, kb = item / nblk, nb = item % nblk, k0 = 64 * kb, n0 = 32 * nb;
    const int ns = srcmap<MAP>(n0 + (lane & 31));
#pragma unroll 8
    for (int i = 0; i < 32; ++i) { const int kk = 2 * i + (lane >> 5); scr[kk * 33 + (lane & 31)] = (ns >= 0) ? W[(size_t)(k0 + kk) * Nsrc + ns] * W8_SCALE : 0.f; }
    LDS_WAIT(); asm volatile("" ::: "memory");
    const int c = lane & 7;
#pragma unroll
    for (int j = 0; j < 4; ++j) { const int n = (lane >> 3) + 8 * j; const LAS float* s = scr + (8 * c) * 33 + n;
        int p0 = __builtin_amdgcn_cvt_pk_fp8_f32(s[0 * 33], s[1 * 33], 0, false); p0 = __builtin_amdgcn_cvt_pk_fp8_f32(s[2 * 33], s[3 * 33], p0, true);
        int p1 = __builtin_amdgcn_cvt_pk_fp8_f32(s[4 * 33], s[5 * 33], 0, false); p1 = __builtin_amdgcn_cvt_pk_fp8_f32(s[6 * 33], s[7 * 33], p1, true);
        u32x2v o; o.x = (unsigned)p0; o.y = (unsigned)p1;
        *(GAS u32x2v*)(WT + (size_t)(dst_row_off + n0 + n) * ldk + dst_col_off + k0 + 8 * c) = o; }
    LDS_WAIT(); asm volatile("" ::: "memory");
}
DI void p0_prologue(Frame& F, const Args& A) {
    LAS float* scr = (LAS float*)(F.lds + RING_OFF + F.wave * 16384);
    const int gw = F.vcu * NWAVES + F.wave, NGW = F.G * NWAVES, lane = lane_id();
    constexpr int I_IN = (DM / 64) * (4096 / 32), I_UQ = (256 / 64) * (1024 / 32), I_QI = (256 / 64) * (256 / 32), I_PBC = (256 / 64) * (1024 / 32), I_PAI = (512 / 64) * (1024 / 32), I_OUT = (DM / 64) * (DM / 32),
                  I_UPI = (DM / 64) * (4096 / 32), I_DN = (DFF / 64) * (DM / 32), I_GLU = (256 / 64) * (256 / 32);
    constexpr int PER_L = I_IN + I_UQ + I_QI + 2 * I_PBC + I_PAI + I_OUT + I_UPI + I_DN + I_GLU;
    for (int it = gw; it < DEPTH * PER_L; it += NGW) {
        const int l = it / PER_L; int r = it % PER_L;
        if (r < I_IN) { if (IN_FP8 && SMALL_FP8 && (r % (4096 / 32)) >= 3584 / 32) p0_transpose_item8<1>(A.in[I_WIN] + (size_t)l * DM * NIN, DM, NIN, 4096, (unsigned char*)wslot(F, l, W_IN), DM, scr, r, lane, 0, -512);
            else if (IN_FP8 && (r % (4096 / 32)) < 3072 / 32) p0_transpose_item8<1>(A.in[I_WIN] + (size_t)l * DM * NIN, DM, NIN, 4096, (unsigned char*)wslot(F, l, W_IN), DM, scr, r, lane);
            else p0_transpose_item<1>(A.in[I_WIN] + (size_t)l * DM * NIN, DM, NIN, 4096, wslot(F, l, W_IN), DM, 0, scr, r, lane); continue; } r -= I_IN;
        if (r < I_UQ) { p0_transpose_item<0>(A.in[I_WUQ] + (size_t)l * 256 * 1024, 256, 1024, 1024, wslot(F, l, W_Q), 256, 0, scr, r, lane); continue; } r -= I_UQ;
        if (r < I_QI) { p0_transpose_item<0>(A.in[I_WQI] + (size_t)l * 256 * 256, 256, 256, 256, wslot(F, l, W_Q), 256, 1024, scr, r, lane); continue; } r -= I_QI;
        if (r < I_PBC) { if (MERGE_FP8) p0_transpose_item8<0>(A.in[I_PB] + (size_t)l * 256 * 1024, 256, 1024, 1024, (unsigned char*)wslot(F, l, W_M), 1024, scr, r, lane, 512); else p0_transpose_item<0>(A.in[I_PB] + (size_t)l * 256 * 1024, 256, 1024, 1024, wslot(F, l, W_M), 1024, 0, scr, r, lane, 512); continue; } r -= I_PBC;
        if (r < I_PBC) { if (MERGE_FP8) p0_transpose_item8<0>(A.in[I_PC] + (size_t)l * 256 * 1024, 256, 1024, 1024, (unsigned char*)wslot(F, l, W_M), 1024, scr, r, lane, 768); else p0_transpose_item<0>(A.in[I_PC] + (size_t)l * 256 * 1024, 256, 1024, 1024, wslot(F, l, W_M), 1024, 0, scr, r, lane, 768); continue; } r -= I_PBC;
        if (r < I_PAI) { if (MERGE_FP8) p0_transpose_item8<0>(A.in[I_PA] + (size_t)l * 512 * 1024, 512, 1024, 1024, (unsigned char*)wslot(F, l, W_M), 1024, scr, r, lane, 0); else p0_transpose_item<0>(A.in[I_PA] + (size_t)l * 512 * 1024, 512, 1024, 1024, wslot(F, l, W_M), 1024, 0, scr, r, lane, 0); continue; } r -= I_PAI;
        if (r < I_OUT) { if (OUT_FP8) p0_transpose_item8<0>(A.in[I_WOUT] + (size_t)l * DM * DM, DM, DM, DM, (unsigned char*)wslot(F, l, W_OUT), DM, scr, r, lane); else p0_transpose_item<0>(A.in[I_WOUT] + (size_t)l * DM * DM, DM, DM, DM, wslot(F, l, W_OUT), DM, 0, scr, r, lane); continue; } r -= I_OUT;
        if (r < I_UPI) { if (UP_FP8) p0_transpose_item8<2>(A.in[I_WUP] + (size_t)l * DM * 4096, DM, 4096, 4096, (unsigned char*)wslot(F, l, W_UP), DM, scr, r, lane); else p0_transpose_item<2>(A.in[I_WUP] + (size_t)l * DM * 4096, DM, 4096, 4096, wslot(F, l, W_UP), DM, 0, scr, r, lane); continue; } r -= I_UPI;
        if (r < I_DN) { if (DOWN_FP8) p0_transpose_item8<0>(A.in[I_WDOWN] + (size_t)l * DFF * DM, DFF, DM, DM, (unsigned char*)wslot(F, l, W_DOWN), DFF, scr, r, lane); else p0_transpose_item<0>(A.in[I_WDOWN] + (size_t)l * DFF * DM, DFF, DM, DM, wslot(F, l, W_DOWN), DFF, 0, scr, r, lane); continue; } r -= I_DN;
        p0_transpose_item<0>(A.in[I_WGLU] + (size_t)l * 256 * 256, 256, 256, 256, wslot(F, l, W_GLU), 256, 0, scr, r, lane);
    }
    if (gw == 0 && lane < 4) ((GAS unsigned*)(wsl(F.ws) + WS_CTL + 65536))[lane] = 0x3F803F80u;
    for (int it = gw * 64 + lane; it < DEPTH * 8 * 2 * 4 * 2 * 64; it += NGW * 64) {
        const int ln = it & 63, sx = (it >> 6) & 1, d0 = (it >> 7) & 3, mt = (it >> 9) & 1, lh = it >> 10;
        const int e = 32 * mt + (ln & 31), hi = ln >> 5;
        const float* wv = A.in[I_WUV] + (size_t)lh * 128 * 64 + e;
        float v[8];
#pragma unroll
        for (int j = 0; j < 8; ++j) { const int d = 32 * d0 + 16 * sx + 8 * (j >> 2) + 4 * hi + (j & 3); v[j] = wv[(size_t)d * 64]; }
        v4u o; o.x = cvtpk(v[0], v[1]); o.y = cvtpk(v[2], v[3]); o.z = cvtpk(v[4], v[5]); o.w = cvtpk(v[6], v[7]);
        *(GAS v4u*)(wslot(F, lh >> 3, W_UVF) + ((size_t)((lh & 7) * 16 + mt * 8 + d0 * 2 + sx) * 64 + ln) * 8) = o;
    }
    for (int it = gw * 64 + lane; it < DEPTH * 256 * 256; it += NGW * 64) {
        const int l = it >> 16, n = (it >> 8) & 255, k = it & 255, g = n >> 6, d = n & 63, g2 = k >> 6, c = k & 63;
        const float v = (g == g2) ? A.in[I_WPOOL][(size_t)l * 4 * 64 * 64 + (size_t)(g * 64 + c) * 64 + d] * A.in[I_PSCALE][l * 256 + n] : 0.f;
        wslot(F, l, W_POOL)[(size_t)n * 256 + k] = (bf16)(cvtpk(v, 0.f) & 0xffffu);
    }
    {
        f32x2v* LAMJ = (f32x2v*)(wsl(F.ws) + WS_LAMJ); f32x2v* BBAR = (f32x2v*)(wsl(F.ws) + WS_BBAR);
        for (int it = gw * 64 + lane; it < DEPTH * 16 * 65 * 64; it += NGW * 64) {
            const int n = it & 63, j = (it >> 6) % 65, lg = (it >> 6) / 65;
            const float step = expf(A.in[I_LOGSTEP][lg]), ar = A.in[I_ARE][lg * 64 + n], ai = A.in[I_AIM][lg * 64 + n];
            const float mag = expf(ar * step * (float)j), ang = ai * step * (float)j;
            float sn, cs; sincosf(ang, &sn, &cs);
            LAMJ[it] = (f32x2v){mag * cs, mag * sn};
        }
        for (int it = gw * 64 + lane; it < DEPTH * 16 * 64 * 16; it += NGW * 64) {
            const int q = it & 15, n = (it >> 4) & 63, lg = it >> 10;
            const float step = expf(A.in[I_LOGSTEP][lg]), ar = A.in[I_ARE][lg * 64 + n], ai = A.in[I_AIM][lg * 64 + n];
            const float mag = expf(ar * step); float sn, cs; sincosf(ai * step, &sn, &cs);
            const float nr = mag * cs - 1.f, ni = mag * sn, den = 1.f / (ar * ar + ai * ai);
            const float fr_ = (nr * ar + ni * ai) * den, fi_ = (ni * ar - nr * ai) * den;
            const float br = A.in[I_BRE][(size_t)lg * 1024 + n * 16 + q], bi = A.in[I_BIM][(size_t)lg * 1024 + n * 16 + q];
            BBAR[it] = (f32x2v){fr_ * br - fi_ * bi, fr_ * bi + fi_ * br};
        }
    }
    {
        __syncthreads();
        LAS float* sil = (LAS float*)(F.lds + RING_OFF);
        float* MOD = (float*)(wsl(F.ws) + WS_MOD);
        for (int it = F.vcu; it < DEPTH * (NMOD / 64); it += F.G) {
            const int l = it / (NMOD / 64), n = (it % (NMOD / 64)) * 64 + lane, kw0 = F.wave * 128;
            LAS float* ms = sil + F.wave * 4096;
            for (int e = lane; e < 4096; e += 64) { const int kk = e >> 5, b = e & 31; const float cv = A.in[I_C][b * DM + kw0 + kk]; ms[e] = cv * sigm(cv); }
            LDS_WAIT(); asm volatile("" ::: "memory");
            float acc[32];
#pragma unroll
            for (int b = 0; b < 32; ++b) acc[b] = 0.f;
            const float* wp = A.in[I_MODW] + (size_t)l * DM * NMOD + (size_t)kw0 * NMOD + n;
#pragma unroll 16
            for (int kk = 0; kk < 128; ++kk) { const float w = ((const GAS float*)wp)[(size_t)kk * NMOD];
#pragma unroll
                for (int b = 0; b < 32; ++b) acc[b] += w * ms[kk * 32 + b]; }
            __syncthreads();
            LAS float* red = (LAS float*)(F.lds + RING_OFF);
#pragma unroll
            for (int b = 0; b < 32; ++b) red[(F.wave * 32 + b) * 64 + lane] = acc[b];
            __syncthreads();
            for (int e = F.wave * 64 + lane; e < 32 * 64; e += NWAVES * 64) { const int b = e >> 6, c = e & 63; float s = 0.f;
#pragma unroll
                for (int w = 0; w < 8; ++w) s += red[(w * 32 + b) * 64 + c];
                const int nn = (it % (NMOD / 64)) * 64 + c; MOD[((size_t)l * 32 + b) * NMOD + nn] = s + A.in[I_MODB][l * NMOD + nn]; }
            __syncthreads();
        }
    }
}
DI void p1_kt(Frame& F, const Args& A) {
    const f32x2v* LAMJ = (const f32x2v*)(wsl(F.ws) + WS_LAMJ); const f32x2v* BBAR = (const f32x2v*)(wsl(F.ws) + WS_BBAR); float* KT = (float*)(wsl(F.ws) + WS_KT);
    const int gt = (F.vcu * NWAVES + F.wave) * 64 + lane_id(), NGT = F.G * NWAVES * 64;
    for (int it = gt; it < DEPTH * 16 * 64 * 256; it += NGT) {
        const int q = it & 15, p = (it >> 4) & 15, j = (it >> 8) & 63, lg = it >> 14;
        const float* cre = A.in[I_CRE] + (size_t)lg * 1024 + p * 64; const float* cim = A.in[I_CIM] + (size_t)lg * 1024 + p * 64;
        float a = 0.f;
#pragma unroll 16
        for (int n = 0; n < 64; ++n) { const f32x2v lj = ((const GAS f32x2v*)LAMJ)[((size_t)lg * 65 + j) * 64 + n], bb = ((const GAS f32x2v*)BBAR)[((size_t)lg * 64 + n) * 16 + q];
            const float tr = lj.x * bb.x - lj.y * bb.y, ti = lj.x * bb.y + lj.y * bb.x;
            a += ((const GAS float*)cre)[n] * tr - ((const GAS float*)cim)[n] * ti; }
        if (j == 0 && p == q) a += A.in[I_DSKIP][lg * 16 + p];
        KT[it] = a;
    }
}
DI void s5_expand(Frame& F, const Args& A, int l) {
    const f32x2v* LAMJ = (const f32x2v*)(wsl(F.ws) + WS_LAMJ) + (size_t)l * 16 * 65 * 64; const f32x2v* BBAR = (const f32x2v*)(wsl(F.ws) + WS_BBAR) + (size_t)l * 16 * 64 * 16;
    const float* KT = (const float*)(wsl(F.ws) + WS_KT) + (size_t)l * 16 * 64 * 256;
    bf16* WY = (bf16*)(wsl(F.ws) + WS_WY); bf16* WE = (bf16*)(wsl(F.ws) + WS_WE);
    const int gt = (F.vcu * NWAVES + F.wave) * 64 + lane_id(), NGT = F.G * NWAVES * 64;
#pragma unroll 4
    for (int it = gt; it < 16 * 1024 * 128; it += NGT) {
        const int k8 = it & 127, row = it >> 7, g = row >> 10, t = (row >> 4) & 63, p = row & 15, k = k8 * 8, s = k >> 4, q0 = k & 15;
        const int lag = t - s, lagc = lag < 0 ? 0 : lag;
        const GAS f32x4* kp = (const GAS f32x4*)(KT + ((size_t)(g * 64 + lagc) * 16 + p) * 16 + q0); f32x4 k0 = kp[0], k1 = kp[1];
        if (lag < 0) { k0 = (f32x4){0.f, 0.f, 0.f, 0.f}; k1 = k0; }
        v4u o; o.x = cvtpk(k0.x, k0.y); o.y = cvtpk(k0.z, k0.w); o.z = cvtpk(k1.x, k1.y); o.w = cvtpk(k1.z, k1.w);
        *(GAS v4u*)(WY + (size_t)row * AS5_LD + k) = o;
    }
    for (int it = gt; it < 16 * 1024 * 16; it += NGT) {
        const int k8 = 128 + (it & 15), row = it >> 4, g = row >> 10, t = (row >> 4) & 63, p = row & 15, k = k8 * 8;
        float v[8];
        { const bool im = k >= 1088; const int n0 = (k - 1024) & 63;
            const float* cre = A.in[I_CRE] + (size_t)(l * 16 + g) * 1024 + p * 64 + n0; const float* cim = A.in[I_CIM] + (size_t)(l * 16 + g) * 1024 + p * 64 + n0;
#pragma unroll
            for (int e = 0; e < 8; ++e) { const f32x2v lj = LAMJ[((size_t)g * 65 + (t + 1)) * 64 + n0 + e];
                v[e] = im ? -(cre[e] * lj.y + cim[e] * lj.x) : (cre[e] * lj.x - cim[e] * lj.y); } }
        v4u o; o.x = cvtpk(v[0], v[1]); o.y = cvtpk(v[2], v[3]); o.z = cvtpk(v[4], v[5]); o.w = cvtpk(v[6], v[7]);
        *(GAS v4u*)(WY + (size_t)row * AS5_LD + k) = o;
    }
    for (int it = gt; it < 16 * 256 * 128; it += NGT) {
        const int k8 = it & 127, row = it >> 7, g = row >> 8, r = row & 255, k = k8 * 8, s = k >> 4, q0 = k & 15;
        float v[8];
        if (r < 128) { const int n = r & 63; const f32x2v lj = LAMJ[((size_t)g * 65 + (63 - s)) * 64 + n];
#pragma unroll
            for (int e = 0; e < 8; ++e) { const f32x2v bb = BBAR[((size_t)g * 64 + n) * 16 + q0 + e]; v[e] = (r < 64) ? (lj.x * bb.x - lj.y * bb.y) : (lj.x * bb.y + lj.y * bb.x); } }
        else {
#pragma unroll
            for (int e = 0; e < 8; ++e) v[e] = 0.f; }
        v4u o; o.x = cvtpk(v[0], v[1]); o.y = cvtpk(v[2], v[3]); o.z = cvtpk(v[4], v[5]); o.w = cvtpk(v[6], v[7]);
        *(GAS v4u*)(WE + (size_t)row * 1024 + k) = o;
    }
}

template <int NR, bool HOIST> DI void norm_rows_t(Frame& F, const float* xin, const bf16* Y, const float* gt, const float* gpost, float* xout,
                  const float* gpre, const float* sc, const float* sh, bf16* Hout, const bool permH, const int XB, const int row_base, const int nrows, const int gw, const int NGW) {
    const int lane = lane_id();
    f32x4 T2[4], G2[4], C2[4];
    if (HOIST) { const int b0 = row_base / SEQ;
#pragma unroll
        for (int j = 0; j < 4; ++j) {
            if (Y) T2[j] = *((const GAS f32x4*)(gt + (size_t)b0 * NMOD) + lane + 64 * j) * *((const GAS f32x4*)gpost + lane + 64 * j);
            if (Hout) { G2[j] = *((const GAS f32x4*)gpre + lane + 64 * j) * (*((const GAS f32x4*)(sc + (size_t)b0 * NMOD) + lane + 64 * j) + 1.0f); C2[j] = *((const GAS f32x4*)(sh + (size_t)b0 * NMOD) + lane + 64 * j); } } }
    for (int m0 = gw; m0 < nrows / NR; m0 += NGW) {
        f32x4 xf[NR][4]; u32x2v xp[NR][4]; u32x2v yp[NR][4];
#pragma unroll
        for (int h = 0; h < NR; ++h) { const int m = row_base + m0 + h * (nrows / NR);
            if (XB & 1) { const GAS u32x2v* xr = (const GAS u32x2v*)(xin + (size_t)m * DM) + lane;
#pragma unroll
                for (int j = 0; j < 4; ++j) xp[h][j] = xr[64 * j]; }
            else { const GAS f32x4* xr = (const GAS f32x4*)(xin + (size_t)m * DM) + lane;
#pragma unroll
                for (int j = 0; j < 4; ++j) xf[h][j] = xr[64 * j]; }
            if (Y) { const GAS u32x2v* yr = (const GAS u32x2v*)(Y + (size_t)m * DM) + lane;
#pragma unroll
                for (int j = 0; j < 4; ++j) yp[h][j] = yr[64 * j]; } }
#pragma unroll
        for (int h = 0; h < NR; ++h) { const int m = row_base + m0 + h * (nrows / NR), b = m / SEQ;
            f32x4 x[4];
#pragma unroll
            for (int j = 0; j < 4; ++j) x[j] = (XB & 1) ? (f32x4){bflo(xp[h][j].x), bfhi(xp[h][j].x), bflo(xp[h][j].y), bfhi(xp[h][j].y)} : xf[h][j];
            if (Y) {
                f32x4 y[4]; float s = 0.f;
#pragma unroll
                for (int j = 0; j < 4; ++j) { y[j] = (f32x4){bflo(yp[h][j].x), bfhi(yp[h][j].x), bflo(yp[h][j].y), bfhi(yp[h][j].y)}; s += (y[j].x * y[j].x + y[j].y * y[j].y) + (y[j].z * y[j].z + y[j].w * y[j].w); }
                const float r = 1.0f / sqrtf(wave_sum(s, lane) * (1.f / DM) + RMS_EPS);
#pragma unroll
                for (int j = 0; j < 4; ++j) { if (HOIST) x[j] = x[j] + T2[j] * (y[j] * r);
                    else { const f32x4 g = *((const GAS f32x4*)gpost + lane + 64 * j), t = *((const GAS f32x4*)(gt + (size_t)b * NMOD) + lane + 64 * j);
                    x[j] = x[j] + t * (y[j] * r * g); } }
                if (XB & 2) { GAS u32x2v* xo = (GAS u32x2v*)(xout + (size_t)m * DM) + lane;
#pragma unroll
                    for (int j = 0; j < 4; ++j) { u32x2v w; w.x = cvtpk(x[j].x, x[j].y); w.y = cvtpk(x[j].z, x[j].w); xo[64 * j] = w;
                        x[j] = (f32x4){bflo(w.x), bfhi(w.x), bflo(w.y), bfhi(w.y)}; } }
                else { GAS f32x4* xo = (GAS f32x4*)(xout + (size_t)m * DM) + lane;
#pragma unroll
                    for (int j = 0; j < 4; ++j) xo[64 * j] = x[j]; }
            }
            if (Hout) {
                float q = 0.f;
#pragma unroll
                for (int j = 0; j < 4; ++j) q += (x[j].x * x[j].x + x[j].y * x[j].y) + (x[j].z * x[j].z + x[j].w * x[j].w);
                const float r = 1.0f / sqrtf(wave_sum(q, lane) * (1.f / DM) + RMS_EPS);
                const int tt = m & 255, hrow = permH ? (m & ~255) + 128 * ((tt >> 2) & 1) + 64 * (tt >> 7) + 16 * (tt & 3) + ((tt >> 3) & 15) : m;
                GAS u32x2v* ho = (GAS u32x2v*)(Hout + (size_t)hrow * DM) + lane;
#pragma unroll
                for (int j = 0; j < 4; ++j) { f32x4 hv;
                    if (HOIST) hv = x[j] * r * G2[j] + C2[j];
                    else { const f32x4 g = *((const GAS f32x4*)gpre + lane + 64 * j), a = *((const GAS f32x4*)(sc + (size_t)b * NMOD) + lane + 64 * j), c = *((const GAS f32x4*)(sh + (size_t)b * NMOD) + lane + 64 * j);
                    hv = x[j] * r * g * (a + 1.0f) + c; }
                    if (UP_FP8 && permH) { int p8 = __builtin_amdgcn_cvt_pk_fp8_f32(pg8::sat8(hv.x), pg8::sat8(hv.y), 0, false); p8 = __builtin_amdgcn_cvt_pk_fp8_f32(pg8::sat8(hv.z), pg8::sat8(hv.w), p8, true); ((GAS unsigned*)((GAS unsigned char*)Hout + (size_t)hrow * DM))[lane + 64 * j] = (unsigned)p8; }
                    else { u32x2v w; w.x = cvtpk(hv.x, hv.y); w.y = cvtpk(hv.z, hv.w); ho[64 * j] = w;
                        if (IN_FP8 && !permH) { int p8 = __builtin_amdgcn_cvt_pk_fp8_f32(pg8::sat8(hv.x), pg8::sat8(hv.y), 0, false); p8 = __builtin_amdgcn_cvt_pk_fp8_f32(pg8::sat8(hv.z), pg8::sat8(hv.w), p8, true); ((GAS unsigned*)((GAS unsigned char*)(wsl(F.ws) + WS_H8) + (size_t)hrow * DM))[lane + 64 * j] = (unsigned)p8; } } }
            }
        }
    }
}
DI void norm_rows(Frame& F, const float* xin, const bf16* Y, const float* gt, const float* gpost, float* xout,
                  const float* gpre, const float* sc, const float* sh, bf16* Hout, const bool permH = false, const int XB = 0) {
    const int gw = F.vcu * NWAVES + F.wave, NGW = F.G * NWAVES;
    if (XB & 1) norm_rows_t<8, false>(F, xin, Y, gt, gpost, xout, gpre, sc, sh, Hout, permH, XB, 0, MTOK, gw, NGW);
    else norm_rows_t<4, false>(F, xin, Y, gt, gpost, xout, gpre, sc, sh, Hout, permH, XB, 0, MTOK, gw, NGW);
}
DI void norm_panel(Frame& F, int pm, const float* xin, const bf16* Y, const float* gt, const float* gpost, float* xout,
                   const float* gpre, const float* sc, const float* sh, bf16* Hout, const bool permH, const int XB) {
    if (XB & 1) norm_rows_t<8, true>(F, xin, Y, gt, gpost, xout, gpre, sc, sh, Hout, permH, XB, pm * 256, 256, F.wave, NWAVES);
    else norm_rows_t<4, true>(F, xin, Y, gt, gpost, xout, gpre, sc, sh, Hout, permH, XB, pm * 256, 256, F.wave, NWAVES);
}
DI void panel_sync() {
    asm volatile("s_waitcnt vmcnt(0)" ::: "memory"); __syncthreads();
    asm volatile("buffer_inv sc0\n\ts_waitcnt vmcnt(0)" ::: "memory"); __syncthreads();
}
template <int r> DI void small_ops_row(Frame& F, const v4u (&w0)[4], const v4u (&w1)[4], const v4u (&wv)[15], float (&sm)[8], const int m0, const int b, const int t0, const int lane,
                                    const bool plane, const int pp, const int grp, const int win, bf16* CQN, bf16* CKVN, bf16* KI, float* WI, bf16* AS5, bf16* PO, const float* gcq, const float* gckv) {
    const int m = m0 + r, t = t0 + r;
            { const v4u w0r = w0[r];
    float a[8] = {bflo(w0r.x), bfhi(w0r.x), bflo(w0r.y), bfhi(w0r.y), bflo(w0r.z), bfhi(w0r.z), bflo(w0r.w), bfhi(w0r.w)};
    float ss = 0.f;
#pragma unroll
    for (int e = 0; e < 8; ++e) ss += a[e] * a[e];
    const float s_cq = wave_sum(lane < 32 ? ss : 0.f, lane), s_kv = wave_sum((lane >= 32 && lane < 48) ? ss : 0.f, lane);
    const float r_cq = 1.0f / sqrtf(s_cq * (1.f / 256.f) + RMS_EPS), r_kv = 1.0f / sqrtf(s_kv * (1.f / 128.f) + RMS_EPS);
    if (lane < 32) { const f32x4 g0 = *(const GAS f32x4*)(gcq + 8 * lane), g1 = *(const GAS f32x4*)(gcq + 8 * lane + 4);
        v4u o; o.x = cvtpk(a[0] * r_cq * g0.x, a[1] * r_cq * g0.y); o.y = cvtpk(a[2] * r_cq * g0.z, a[3] * r_cq * g0.w); o.z = cvtpk(a[4] * r_cq * g1.x, a[5] * r_cq * g1.y); o.w = cvtpk(a[6] * r_cq * g1.z, a[7] * r_cq * g1.w);
        *(GAS v4u*)(CQN + (size_t)m * 256 + 8 * lane) = o; }
    else if (lane < 48) { const int c = 8 * (lane - 32); const f32x4 g0 = *(const GAS f32x4*)(gckv + c), g1 = *(const GAS f32x4*)(gckv + c + 4);
        v4u o; o.x = cvtpk(a[0] * r_kv * g0.x, a[1] * r_kv * g0.y); o.y = cvtpk(a[2] * r_kv * g0.z, a[3] * r_kv * g0.w); o.z = cvtpk(a[4] * r_kv * g1.x, a[5] * r_kv * g1.y); o.w = cvtpk(a[6] * r_kv * g1.z, a[7] * r_kv * g1.w);
        *(GAS v4u*)(CKVN + (size_t)m * 128 + c) = o; }
    else if (lane < 52) { *(GAS v4u*)(KI + (size_t)m * 32 + 8 * (lane - 48)) = w0r; }
    else if (lane == 52) { *(GAS f32x4*)(WI + (size_t)m * 8) = (f32x4){a[0], a[1], a[2], a[3]}; *(GAS f32x4*)(WI + (size_t)m * 8 + 4) = (f32x4){a[4], a[5], a[6], a[7]}; } }
    const int kc = t >> 6, s = t & 63;
    if (lane >= 53) { const int p = lane - 53, g = p >> 1, q0 = 8 * (p & 1);
        *(GAS v4u*)(AS5 + (size_t)(g * 1024 + b * 32 + kc) * AS5_LD + s * 16 + q0) = w0[r]; }
    if (lane <= 20) { const int p = lane + 11, g = p >> 1, q0 = 8 * (p & 1);
        *(GAS v4u*)(AS5 + (size_t)(g * 1024 + b * 32 + kc) * AS5_LD + s * 16 + q0) = w1[r]; }
    if (plane) {
        const v4u w1r = w1[r];
        const float u[8] = {bflo(w1r.x), bfhi(w1r.x), bflo(w1r.y), bfhi(w1r.y), bflo(w1r.z), bfhi(w1r.z), bflo(w1r.w), bfhi(w1r.w)};
        if constexpr (r == 0) {
#pragma unroll
            for (int e = 0; e < 8; ++e) sm[e] = u[e];
#pragma unroll
            for (int i = 0; i < 15; ++i) { sm[0] += bflo(wv[i].x); sm[1] += bfhi(wv[i].x); sm[2] += bflo(wv[i].y); sm[3] += bfhi(wv[i].y); sm[4] += bflo(wv[i].z); sm[5] += bfhi(wv[i].z); sm[6] += bflo(wv[i].w); sm[7] += bfhi(wv[i].w); }
        } else {
            const unsigned k3 = grp == 3 ? ~0u : 0u, k2 = grp == 2 ? ~0u : 0u, k1 = grp == 1 ? ~0u : 0u, k0 = grp == 0 ? ~0u : 0u;
            const v4u c3 = wv[15 - r], c2 = wv[7 - r], c1 = wv[3 - r], c0 = (r == 1) ? wv[0] : w1[r - 2 < 0 ? 0 : r - 2];
            v4u lv; lv.x = (c3.x & k3) | (c2.x & k2) | (c1.x & k1) | (c0.x & k0); lv.y = (c3.y & k3) | (c2.y & k2) | (c1.y & k1) | (c0.y & k0);
            lv.z = (c3.z & k3) | (c2.z & k2) | (c1.z & k1) | (c0.z & k0); lv.w = (c3.w & k3) | (c2.w & k2) | (c1.w & k1) | (c0.w & k0);
#pragma unroll
            for (int e = 0; e < 8; ++e) sm[e] += u[e];
            sm[0] -= bflo(lv.x); sm[1] -= bfhi(lv.x); sm[2] -= bflo(lv.y); sm[3] -= bfhi(lv.y); sm[4] -= bflo(lv.z); sm[5] -= bfhi(lv.z); sm[6] -= bflo(lv.w); sm[7] -= bfhi(lv.w);
        }
        const int cnt = (t + 1 < win) ? (t + 1) : win; const float ic = 1.0f / (float)cnt;
        v4u o; o.x = cvtpk(sm[0] * ic - u[0], sm[1] * ic - u[1]); o.y = cvtpk(sm[2] * ic - u[2], sm[3] * ic - u[3]); o.z = cvtpk(sm[4] * ic - u[4], sm[5] * ic - u[5]); o.w = cvtpk(sm[6] * ic - u[6], sm[7] * ic - u[7]);
        *(GAS v4u*)(PO + (size_t)m * 256 + 8 * pp) = o;
    }
}
DI void small_ops(Frame& F, const Args& A, int l) {
    const int gw = F.vcu * NWAVES + F.wave, NGW = F.G * NWAVES, lane = lane_id();
    const bf16* ZS = (const bf16*)(wsl(F.ws) + WS_ZS);
    bf16* CQN = (bf16*)(wsl(F.ws) + WS_CQN); bf16* CKVN = (bf16*)(wsl(F.ws) + WS_CKVN); bf16* KI = (bf16*)(wsl(F.ws) + WS_KI); float* WI = (float*)(wsl(F.ws) + WS_WI);
    bf16* AS5 = (bf16*)(wsl(F.ws) + WS_AS5); bf16* PO = (bf16*)(wsl(F.ws) + WS_POOLED);
    const float* gcq = A.in[I_GCQ] + l * 256; const float* gckv = A.in[I_GCKV] + l * 128;
#pragma nounroll
    for (int mg = gw; mg < MTOK / 4; mg += NGW) {
        const int m0 = mg * 4, b = m0 / SEQ, t0 = m0 % SEQ;
        const bf16* zr0 = ZS + (size_t)m0 * 1024;
        v4u w0[4], w1[4];
#pragma unroll
        for (int r = 0; r < 4; ++r) { w0[r] = *(const GAS v4u*)(zr0 + (size_t)r * 1024 + 8 * lane); w1[r] = *(const GAS v4u*)(zr0 + (size_t)r * 1024 + 512 + 8 * lane); }
        const bool plane = lane >= 21 && lane <= 52; const int pp = lane - 21, grp = (pp >> 3) & 3, win = 2 << grp;
        v4u wv[15];
#define SO_LW(i) { wv[(i) - 1] = (v4u){0u, 0u, 0u, 0u}; if (plane && (i) < win && (i) <= t0) wv[(i) - 1] = *(const GAS v4u*)(zr0 - (size_t)(i) * 1024 + 512 + 8 * lane); }
        SO_LW(1) SO_LW(2) SO_LW(3) SO_LW(4) SO_LW(5) SO_LW(6) SO_LW(7) SO_LW(8) SO_LW(9) SO_LW(10) SO_LW(11) SO_LW(12) SO_LW(13) SO_LW(14) SO_LW(15)
#undef SO_LW
        float sm[8];
        small_ops_row<0>(F, w0, w1, wv, sm, m0, b, t0, lane, plane, pp, grp, win, CQN, CKVN, KI, WI, AS5, PO, gcq, gckv);
        small_ops_row<1>(F, w0, w1, wv, sm, m0, b, t0, lane, plane, pp, grp, win, CQN, CKVN, KI, WI, AS5, PO, gcq, gckv);
        small_ops_row<2>(F, w0, w1, wv, sm, m0, b, t0, lane, plane, pp, grp, win, CQN, CKVN, KI, WI, AS5, PO, gcq, gckv);
        small_ops_row<3>(F, w0, w1, wv, sm, m0, b, t0, lane, plane, pp, grp, win, CQN, CKVN, KI, WI, AS5, PO, gcq, gckv);
    }
}
DI void s5_scan(Frame& F, int l) {
    const int gw = F.wave * F.G + F.vcu, NGW = F.G * NWAVES, n = lane_id();
    const f32x2v* LAMJ = (const f32x2v*)(wsl(F.ws) + WS_LAMJ) + (size_t)l * 16 * 65 * 64; const float* E = (const float*)(wsl(F.ws) + WS_E); bf16* AS5 = (bf16*)(wsl(F.ws) + WS_AS5);
    for (int it = gw; it < 16 * BATCH; it += NGW) {
        const int g = it >> 5, b = it & 31; const f32x2v lam = LAMJ[((size_t)g * 65 + 64) * 64 + n];
        float sr = 0.f, si = 0.f; const size_t row0 = (size_t)g * 1024 + b * 32;
        float er[32], ei[32];
#pragma unroll
        for (int k = 0; k < 32; ++k) { er[k] = ((const GAS float*)E)[(row0 + k) * 128 + n]; ei[k] = ((const GAS float*)E)[(row0 + k) * 128 + 64 + n]; }
#pragma unroll
        for (int k = 0; k < 32; ++k) {
            GAS bf16* ar = (GAS bf16*)(AS5 + (row0 + k) * AS5_LD + 1024);
            ar[n] = (bf16)(cvtpk(sr, 0.f) & 0xffffu); ar[64 + n] = (bf16)(cvtpk(si, 0.f) & 0xffffu);
            const float nr = lam.x * sr - lam.y * si + er[k], ni = lam.x * si + lam.y * sr + ei[k]; sr = nr; si = ni;
        }
    }
}
DI void conv_fixup(Frame& F, const Args& A, int l, const int pm) {
    const int gt = pm * 512 + F.wave * 64 + lane_id(), NGT = 1 << 30;
    const float* HALO = (const float*)(wsl(F.ws) + WS_HALO); bf16* A2 = (bf16*)(wsl(F.ws) + WS_A2);
    const float* cw = A.in[I_CONVW] + (size_t)l * 3 * 4096; const float* cb = A.in[I_CONVB] + (size_t)l * 4096;
    { const int it = gt;
        const int R = it >> 8, j0 = (it & 255) * 8, t0 = R * 128; const bool first = (t0 % SEQ) == 0;
        float f0[8], f1[8];
#pragma unroll
        for (int h = 0; h < 2; ++h) {
            const int j = j0 + 4 * h;
            f32x4 r0[2], r1[2];
#pragma unroll
            for (int gv = 0; gv < 2; ++gv) { const int c = gv * 2048 + j;
                const f32x4 w0 = *(const GAS f32x4*)(cw + c), w1 = *(const GAS f32x4*)(cw + 4096 + c), w2 = *(const GAS f32x4*)(cw + 8192 + c), bb = *(const GAS f32x4*)(cb + c);
                const f32x4 z = {0.f, 0.f, 0.f, 0.f};
                const f32x4 p2 = first ? z : *(const GAS f32x4*)(HALO + ((size_t)(R - 1) * 4 + 2) * 4096 + c), p3 = first ? z : *(const GAS f32x4*)(HALO + ((size_t)(R - 1) * 4 + 3) * 4096 + c);
                const f32x4 q0 = *(const GAS f32x4*)(HALO + ((size_t)R * 4 + 0) * 4096 + c), q1 = *(const GAS f32x4*)(HALO + ((size_t)R * 4 + 1) * 4096 + c);
                if (UP_FP8) { const float usc = 1.0f / W8_SCALE; r0[gv] = bb + (w0 * p2 + w1 * p3 + w2 * q0) * usc; r1[gv] = bb + (w0 * p3 + w1 * q0 + w2 * q1) * usc; }
                else { r0[gv] = bb + w0 * p2 + w1 * p3 + w2 * q0; r1[gv] = bb + w0 * p3 + w1 * q0 + w2 * q1; } }
            f0[4 * h] = gelu_t(r0[0].x) * r0[1].x; f0[4 * h + 1] = gelu_t(r0[0].y) * r0[1].y; f0[4 * h + 2] = gelu_t(r0[0].z) * r0[1].z; f0[4 * h + 3] = gelu_t(r0[0].w) * r0[1].w;
            f1[4 * h] = gelu_t(r1[0].x) * r1[1].x; f1[4 * h + 1] = gelu_t(r1[0].y) * r1[1].y; f1[4 * h + 2] = gelu_t(r1[0].z) * r1[1].z; f1[4 * h + 3] = gelu_t(r1[0].w) * r1[1].w;
            if (DOWN_FP8) {
#pragma unroll
                for (int q = 0; q < 4; ++q) { f0[4 * h + q] = pg8::sat8(f0[4 * h + q]); f1[4 * h + q] = pg8::sat8(f1[4 * h + q]); } }
        }
        if (DOWN_FP8) { GAS unsigned char* A8 = (GAS unsigned char*)A2; u32x2v w0_, w1_;
            int p = __builtin_amdgcn_cvt_pk_fp8_f32(f0[0], f0[1], 0, false); p = __builtin_amdgcn_cvt_pk_fp8_f32(f0[2], f0[3], p, true); w0_.x = (unsigned)p; p = __builtin_amdgcn_cvt_pk_fp8_f32(f0[4], f0[5], 0, false); p = __builtin_amdgcn_cvt_pk_fp8_f32(f0[6], f0[7], p, true); w0_.y = (unsigned)p;
            p = __builtin_amdgcn_cvt_pk_fp8_f32(f1[0], f1[1], 0, false); p = __builtin_amdgcn_cvt_pk_fp8_f32(f1[2], f1[3], p, true); w1_.x = (unsigned)p; p = __builtin_amdgcn_cvt_pk_fp8_f32(f1[4], f1[5], 0, false); p = __builtin_amdgcn_cvt_pk_fp8_f32(f1[6], f1[7], p, true); w1_.y = (unsigned)p;
            *(GAS u32x2v*)(A8 + (size_t)t0 * 2048 + j0) = w0_; *(GAS u32x2v*)(A8 + (size_t)(t0 + 1) * 2048 + j0) = w1_; }
        else {
        *(GAS v4u*)(A2 + (size_t)t0 * 2048 + j0) = (v4u){cvtpk(f0[0], f0[1]), cvtpk(f0[2], f0[3]), cvtpk(f0[4], f0[5]), cvtpk(f0[6], f0[7])};
        *(GAS v4u*)(A2 + (size_t)(t0 + 1) * 2048 + j0) = (v4u){cvtpk(f1[0], f1[1]), cvtpk(f1[2], f1[3]), cvtpk(f1[4], f1[5]), cvtpk(f1[6], f1[7])}; }
    }
}
DI void conv_gate(Frame& F, const Args& A, int l) {
    const int gw = F.vcu * NWAVES + F.wave, NGW = F.G * NWAVES, lane = lane_id();
    const bf16* U = (const bf16*)(wsl(F.ws) + WS_U); bf16* A2 = (bf16*)(wsl(F.ws) + WS_A2);
    const float* cw = A.in[I_CONVW] + (size_t)l * 3 * 4096; const float* cb = A.in[I_CONVB] + (size_t)l * 4096;
    for (int it = gw; it < (MTOK / 64) * 4; it += NGW) {
        const int cbk = it & 3, run = it >> 2, j0 = cbk * 512 + lane * 8, t0 = run * 64;
        float wg[3][8], wv[3][8], bg[8], bv[8];
#pragma unroll
        for (int k = 0; k < 3; ++k)
#pragma unroll
            for (int e = 0; e < 8; ++e) { wg[k][e] = cw[k * 4096 + j0 + e]; wv[k][e] = cw[k * 4096 + 2048 + j0 + e]; }
#pragma unroll
        for (int e = 0; e < 8; ++e) { bg[e] = cb[j0 + e]; bv[e] = cb[2048 + j0 + e]; }
        v4u g1 = {0, 0, 0, 0}, g2 = {0, 0, 0, 0}, v1 = {0, 0, 0, 0}, v2 = {0, 0, 0, 0};
        if ((t0 % SEQ) != 0) { const bf16* p1 = U + (size_t)(t0 - 1) * 4096 + j0; const bf16* p2 = U + (size_t)(t0 - 2) * 4096 + j0;
            g1 = *(const GAS v4u*)p1; v1 = *(const GAS v4u*)(p1 + 2048); g2 = *(const GAS v4u*)p2; v2 = *(const GAS v4u*)(p2 + 2048); }
        v4u gn = *(const GAS v4u*)(U + (size_t)t0 * 4096 + j0), vn = *(const GAS v4u*)(U + (size_t)t0 * 4096 + j0 + 2048), gn2, vn2;
        gn2 = *(const GAS v4u*)(U + (size_t)(t0 + 1) * 4096 + j0); vn2 = *(const GAS v4u*)(U + (size_t)(t0 + 1) * 4096 + j0 + 2048);
        for (int r = 0; r < 64; ++r) {
            const v4u g0 = gn, v0 = vn; gn = gn2; vn = vn2;
            if (r + 2 < 64) { const bf16* p2 = U + (size_t)(t0 + r + 2) * 4096 + j0; gn2 = *(const GAS v4u*)p2; vn2 = *(const GAS v4u*)(p2 + 2048); }
            const unsigned G0[4] = {g0.x, g0.y, g0.z, g0.w}, G1[4] = {g1.x, g1.y, g1.z, g1.w}, G2[4] = {g2.x, g2.y, g2.z, g2.w};
            const unsigned V0[4] = {v0.x, v0.y, v0.z, v0.w}, V1[4] = {v1.x, v1.y, v1.z, v1.w}, V2[4] = {v2.x, v2.y, v2.z, v2.w};
            unsigned o[4];
#pragma unroll
            for (int h = 0; h < 4; ++h) {
                const float ga = bg[2 * h] + wg[0][2 * h] * bflo(G2[h]) + wg[1][2 * h] * bflo(G1[h]) + wg[2][2 * h] * bflo(G0[h]);
                const float gb = bg[2 * h + 1] + wg[0][2 * h + 1] * bfhi(G2[h]) + wg[1][2 * h + 1] * bfhi(G1[h]) + wg[2][2 * h + 1] * bfhi(G0[h]);
                const float va = bv[2 * h] + wv[0][2 * h] * bflo(V2[h]) + wv[1][2 * h] * bflo(V1[h]) + wv[2][2 * h] * bflo(V0[h]);
                const float vb = bv[2 * h + 1] + wv[0][2 * h + 1] * bfhi(V2[h]) + wv[1][2 * h + 1] * bfhi(V1[h]) + wv[2][2 * h + 1] * bfhi(V0[h]);
                o[h] = cvtpk(gelu_t(ga) * va, gelu_t(gb) * vb);
            }
            *(GAS v4u*)(A2 + (size_t)(t0 + r) * 2048 + j0) = (v4u){o[0], o[1], o[2], o[3]};
            g2 = g1; v2 = v1; g1 = g0; v1 = v0;
        }
    }
}

using f32x16 = __attribute__((ext_vector_type(16))) float;
#define SBAR() __builtin_amdgcn_sched_barrier(0)
using s16x4 = __attribute__((ext_vector_type(4))) short;
DI void dsa_unit(int i2, int e, int& b, int& qb) { b = i2 >> 3; const int kk = i2 & 7; qb = (e >> 1) * 16 + ((e & 1) ? 15 - kk : kk); }
DI unsigned swap32(unsigned v) { auto rr = __builtin_amdgcn_permlane32_swap(v, v, false, false); return rr[0] ^ rr[1] ^ v; }

#ifndef REP_ISC
#define REP_ISC 1
#endif
#ifndef REP_IBI
#define REP_IBI 1
#endif
#define IDXREP(n) _Pragma("nounroll") for (int _r = 0; _r < (n); ++_r)
#define RELU(x) __int_as_float(max(__float_as_int(x), 0))
DI void indexer_wave(Frame& F, int b, int q4) {
    const int lane = lane_id(), kl = lane & 31, hi = lane >> 5;
    const bf16* QQ = (const bf16*)(wsl(F.ws) + WS_QQ); const float* WI = (const float*)(wsl(F.ws) + WS_WI); unsigned* SELQ = (unsigned*)(wsl(F.ws) + WS_SELQ);
    const int s0 = q4 * 4, c = s0 >> 6, nkeys = 64 * (c + 1), ntile = nkeys >> 5, NT = c + 1, ntile_eff = 2 * (NT + (NT & 1));
    const size_t qrow = (size_t)b * SEQ + s0;
    const bf16* qp = QQ + (qrow + (kl >> 3)) * 1280 + 1024 + (kl & 7) * 32 + 8 * hi;
    const bf16x8 qa0 = *(const GAS bf16x8*)qp, qa1 = *(const GAS bf16x8*)(qp + 16);
    f32x2v w2[8];
#pragma unroll
    for (int qq = 0; qq < 4; ++qq) { const f32x4 wv = *(const GAS f32x4*)(WI + (qrow + qq) * 8 + 4 * hi); w2[2 * qq] = (f32x2v){wv.x, wv.y}; w2[2 * qq + 1] = (f32x2v){wv.z, wv.w}; }
    f32x2v sc[64];
    const LAS unsigned char* kimg = F.lds + RING_OFF;
    const int ksw = (kl >> 2) & 3;
    int zs = 0; asm volatile("" : "+s"(zs));
    const float NINF = __uint_as_float(0xff800000u | (unsigned)zs);
#define IDX_TILE_MFMA(T, CC) { const LAS unsigned char* kp = kimg + ((T) * 32 + kl) * 64; \
        const bf16x8 kb0 = *(const LAS bf16x8*)(kp + ((hi ^ ksw) << 4)), kb1 = *(const LAS bf16x8*)(kp + (((2 + hi) ^ ksw) << 4)); \
        CC = (f32x16){0.f, 0.f, 0.f, 0.f, 0.f, 0.f, 0.f, 0.f, 0.f, 0.f, 0.f, 0.f, 0.f, 0.f, 0.f, 0.f}; \
        CC = __builtin_amdgcn_mfma_f32_32x32x16_bf16(qa0, kb0, CC, 0, 0, 0); CC = __builtin_amdgcn_mfma_f32_32x32x16_bf16(qa1, kb1, CC, 0, 0, 0); }
#define IDX_TILE_VALU(T, CC) { float sq[4]; \
        _Pragma("unroll") for (int qq = 0; qq < 4; ++qq) { f32x2v p = (f32x2v){RELU(CC[4 * qq]), RELU(CC[4 * qq + 1])} * w2[2 * qq]; p = (f32x2v){RELU(CC[4 * qq + 2]), RELU(CC[4 * qq + 3])} * w2[2 * qq + 1] + p; sq[qq] = p.x + p.y; } \
        const auto r0 = __builtin_amdgcn_permlane32_swap(__float_as_uint(sq[0]), __float_as_uint(sq[2]), false, false); \
        const auto r1 = __builtin_amdgcn_permlane32_swap(__float_as_uint(sq[1]), __float_as_uint(sq[3]), false, false); \
        sc[T].x = __uint_as_float(r0[0]) + __uint_as_float(r0[1]); sc[T].y = __uint_as_float(r1[0]) + __uint_as_float(r1[1]); }
    IDXREP(REP_ISC)
#pragma unroll
    for (int t = 0; t < 64; t += 2) {
        if (t < ntile) {
            f32x16 ccA, ccB;
            IDX_TILE_MFMA(t, ccA); IDX_TILE_MFMA(t + 1, ccB);
            IDX_TILE_VALU(t, ccA); IDX_TILE_VALU(t + 1, ccB);
            asm volatile("" : "+v"(sc[t]), "+v"(sc[t + 1]));
        } else { sc[t].x = NINF; sc[t].y = NINF; sc[t + 1].x = NINF; sc[t + 1].y = NINF; }
    }
#undef IDX_TILE_MFMA
#undef IDX_TILE_VALU
    f32x2v T = {NINF, NINF};
    const float tvn = __uint_as_float(0x7fc00000u | (unsigned)zs);
    f32x2v tv = {tvn, tvn};
    unsigned need0 = 0u, need1 = 0u;
    IDXREP(REP_IBI) {
    if (nkeys > 256) {
        unsigned am0 = 0u, am1 = 0u;
#pragma unroll
        for (int t = 0; t < 64; ++t) if (t < ntile) { am0 = max(am0, __float_as_uint(sc[t].x) & 0x7fffffffu); am1 = max(am1, __float_as_uint(sc[t].y) & 0x7fffffffu); }
#pragma unroll
        for (int o = 1; o < 32; o <<= 1) { am0 = max(am0, (unsigned)__builtin_amdgcn_ds_bpermute((lane ^ o) << 2, (int)am0)); am1 = max(am1, (unsigned)__builtin_amdgcn_ds_bpermute((lane ^ o) << 2, (int)am1)); }
        f32x2v hi2 = {__uint_as_float(am0), __uint_as_float(am1)};
        f32x2v lo2 = {-1.001f * hi2.x - 1e-30f, -1.001f * hi2.y - 1e-30f};
        bool d0 = false, d1 = false; unsigned ch0 = 0u, ch1 = 0u;
        const f32x2v big2 = {1.2676506002282294e30f, 1.2676506002282294e30f};
#pragma nounroll
        for (int it = 0; it < 64; ++it) {
            if (__all(d0 && d1)) break;
            const f32x2v mid = (lo2 + hi2) * 0.5f;
            const f32x2v c2 = mid * (-1.2676506002282294e30f);
            f32x2v cA = {0.f, 0.f}, cB = {0.f, 0.f}, cC = {0.f, 0.f}, cD = {0.f, 0.f};
#pragma unroll
            for (int t8 = 0; t8 < 8; ++t8) {
                if (t8 * 8 < ntile) {
#pragma unroll
                    for (int tt = 0; tt < 8; tt += 4) { f32x2v i0, i1, i2, i3;
                        asm("v_pk_fma_f32 %0, %1, %2, %3 clamp" : "=v"(i0) : "v"(sc[t8 * 8 + tt]), "v"(big2), "v"(c2)); asm("v_pk_fma_f32 %0, %1, %2, %3 clamp" : "=v"(i1) : "v"(sc[t8 * 8 + tt + 1]), "v"(big2), "v"(c2));
                        asm("v_pk_fma_f32 %0, %1, %2, %3 clamp" : "=v"(i2) : "v"(sc[t8 * 8 + tt + 2]), "v"(big2), "v"(c2)); asm("v_pk_fma_f32 %0, %1, %2, %3 clamp" : "=v"(i3) : "v"(sc[t8 * 8 + tt + 3]), "v"(big2), "v"(c2));
                        cA += i0; cB += i1; cC += i2; cD += i3; } }
            }
            const f32x2v cnt = (cA + cB) + (cC + cD);
            unsigned pk = (unsigned)(int)(cnt.x + 0.5f) | ((unsigned)(int)(cnt.y + 0.5f) << 16);
            pk += (unsigned)__builtin_amdgcn_update_dpp(0, (int)pk, 0xB1, 0xf, 0xf, true);
            pk += (unsigned)__builtin_amdgcn_update_dpp(0, (int)pk, 0x4E, 0xf, 0xf, true);
            pk += (unsigned)__builtin_amdgcn_update_dpp(0, (int)pk, 0x141, 0xf, 0xf, true);
            pk += (unsigned)__builtin_amdgcn_update_dpp(0, (int)pk, 0x140, 0xf, 0xf, true);
            pk += (unsigned)__builtin_amdgcn_ds_swizzle((int)pk, 0x401F);
            const unsigned n0 = pk & 0xffffu, n1 = pk >> 16;
            if (!d0) { if (!(mid.x > lo2.x && mid.x < hi2.x)) { T.x = hi2.x; tv.x = hi2.x; need0 = 256u - ch0; d0 = true; }
                       else if (n0 > 256u) lo2.x = mid.x; else if (n0 < 256u) { hi2.x = mid.x; ch0 = n0; } else { T.x = mid.x; d0 = true; } }
            if (!d1) { if (!(mid.y > lo2.y && mid.y < hi2.y)) { T.y = hi2.y; tv.y = hi2.y; need1 = 256u - ch1; d1 = true; }
                       else if (n1 > 256u) lo2.y = mid.y; else if (n1 < 256u) { hi2.y = mid.y; ch1 = n1; } else { T.y = mid.y; d1 = true; } }
        }
        if (!d0) { T.x = hi2.x; tv.x = hi2.x; need0 = 256u - ch0; }
        if (!d1) { T.y = hi2.y; tv.y = hi2.y; need1 = 256u - ch1; }
    }
    }
    const bool anytie = __any(need0 != 0u || need1 != 0u);
    if (!anytie) {
#pragma unroll
        for (int t = 0; t < 64; ++t) {
            if (t < ntile_eff) {
                unsigned long long m0 = 0ull, m1 = 0ull;
                if (t < ntile) { m0 = __ballot(sc[t].x > T.x); m1 = __ballot(sc[t].y > T.y); }
                if (lane == 0) *(GAS v4u*)(SELQ + ((size_t)(b * 32 + (t >> 1)) * 2 + (t & 1)) * SEQ + s0) = (v4u){(unsigned)m0, (unsigned)m1, (unsigned)(m0 >> 32), (unsigned)(m1 >> 32)};
            }
        }
    } else {
        unsigned run0 = 0u, run1 = 0u;
#pragma nounroll
        for (int tg = 0; tg < 8; ++tg) {
#pragma unroll
            for (int tt = 0; tt < 8; ++tt) {
                f32x2v sv = sc[tt];
#pragma unroll
                for (int g2 = 1; g2 < 8; ++g2) if (tg == g2) sv = sc[g2 * 8 + tt];
                const int t = tg * 8 + tt;
                if (t < ntile_eff) {
                    unsigned long long m0 = 0ull, m1 = 0ull;
                    if (t < ntile) {
                        const unsigned long long e0 = __ballot(sv.x == tv.x), e1 = __ballot(sv.y == tv.y);
                        const unsigned eh0 = hi ? (unsigned)(e0 >> 32) : (unsigned)e0, eh1 = hi ? (unsigned)(e1 >> 32) : (unsigned)e1;
                        const unsigned below = (1u << kl) - 1u;
                        const bool take0 = (sv.x == tv.x) && (run0 + (unsigned)__builtin_popcount(eh0 & below) < need0), take1 = (sv.y == tv.y) && (run1 + (unsigned)__builtin_popcount(eh1 & below) < need1);
                        run0 += (unsigned)__builtin_popcount(eh0); run1 += (unsigned)__builtin_popcount(eh1);
                        m0 = __ballot(sv.x > T.x || take0); m1 = __ballot(sv.y > T.y || take1); }
                    if (lane == 0) *(GAS v4u*)(SELQ + ((size_t)(b * 32 + (t >> 1)) * 2 + (t & 1)) * SEQ + s0) = (v4u){(unsigned)m0, (unsigned)m1, (unsigned)(m0 >> 32), (unsigned)(m1 >> 32)};
                }
            }
        }
    }
}
#ifndef REP_IW
#define REP_IW 1
#endif
#ifndef REP_IST
#define REP_IST 1
#endif
#define IDXREP2(n) _Pragma("nounroll") for (int _r2 = 0, _n2 = ({ int _t = (n); asm volatile("" : "+s"(_t)); _t; }); _r2 < _n2; ++_r2)
DI void indexer_phase(Frame& F) {
#pragma nounroll
    for (int i2 = F.vcu; i2 < 256; i2 += F.G) {
#pragma nounroll
        for (int e = 0; e < 8; ++e) { int b, qb; dsa_unit(i2, e, b, qb);
            const int nkeys = 64 * ((qb >> 1) + 1), tid = F.wave * 64 + lane_id();
            const bf16* KI = (const bf16*)(wsl(F.ws) + WS_KI) + (size_t)b * SEQ * 32;
            IDXREP2(REP_IST) {
            __syncthreads();
#pragma nounroll
            for (int i0 = 0; i0 < nkeys * 4; i0 += 8 * NWAVES * 64) {
                v4u tmp[8];
#pragma unroll
                for (int j = 0; j < 8; ++j) { const int i = i0 + j * NWAVES * 64 + tid; if (i < nkeys * 4) tmp[j] = *(const GAS v4u*)(KI + (size_t)i * 8); }
#pragma unroll
                for (int j = 0; j < 8; ++j) { const int i = i0 + j * NWAVES * 64 + tid, key = i >> 2, c = i & 3; if (i < nkeys * 4) *(LAS v4u*)(F.lds + RING_OFF + key * 64 + ((c ^ ((key >> 2) & 3)) << 4)) = tmp[j]; }
            }
            __syncthreads();
            }
            IDXREP2(REP_IW) { indexer_wave(F, b, qb * 8 + F.wave); } } }
    __syncthreads();
}

constexpr int AD = 128, KVBLK = 64;
constexpr float ATT_SCALE = 0.088388347648318440f, ATT_THR = 8.f;
constexpr size_t SHM_V = KVBLK * AD * 2, SHM_K = KVBLK * AD * 2;
#define KSWZ(row, colB) ((row) * 256 + ((colB) ^ (((row) & 7) << 4)))
typedef __bf16 bf16x2_t __attribute__((ext_vector_type(2)));
DI unsigned cvtpk_c(float lo, float hi_) { f32x2v v = {lo, hi_}; bf16x2_t bb = __builtin_convertvector(v, bf16x2_t); return __builtin_bit_cast(unsigned, bb); }
DI int crow(int r, int hi) { return (r & 3) + 8 * (r >> 2) + 4 * hi; }
DI void partialSM(f32x16& p0, f32x16& p1, float& m_reg, float& mn, float& alpha, unsigned w0, unsigned w1, float tl, float na, int hi) {
    constexpr float C = ATT_SCALE * 1.4426950408889634f;
    const int s0 = (int)(w0 >> (4 * hi)), s1 = (int)(w1 >> (4 * hi)); const float tlh = tl - (float)(4 * hi), tlh1 = tlh - 32.f;
    const int NEGB = 0xF149F2CA;
#pragma unroll
    for (int r = 0; r < 16; ++r) { const int cpos = (r & 3) + 8 * (r >> 2);
        const int m0 = __builtin_amdgcn_sbfe(s0, cpos, 1), m1 = __builtin_amdgcn_sbfe(s1, cpos, 1);
        const float d0 = tlh - (float)cpos, d1 = tlh1 - (float)cpos;
        { const float x0 = fmaf(fabsf(d0), na, p0[r]), x1 = fmaf(fabsf(d1), na, p1[r]); float y0, y1;
          asm("v_bfi_b32 %0, %1, %2, %3" : "=v"(y0) : "v"(m0), "v"(x0), "s"(NEGB)); asm("v_bfi_b32 %0, %1, %2, %3" : "=v"(y1) : "v"(m1), "v"(x1), "s"(NEGB));
          p0[r] = y0; p1[r] = y1; }
        if ((r & 3) == 3) SBAR(); }
    float pmax = p0[0];
#pragma unroll
    for (int r = 1; r < 16; ++r) pmax = fmaxf(pmax, p0[r]);
#pragma unroll
    for (int r = 0; r < 16; ++r) pmax = fmaxf(pmax, p1[r]);
    { auto rr = __builtin_amdgcn_permlane32_swap(__float_as_uint(pmax), __float_as_uint(pmax), false, false);
      pmax = fmaxf(__uint_as_float(rr[0]), __uint_as_float(rr[1])); }
    if (__builtin_expect(__all(pmax - m_reg <= ATT_THR / ATT_SCALE), 1)) { mn = m_reg; alpha = 1.f; }
    else { mn = fmaxf(m_reg, pmax); alpha = __builtin_amdgcn_exp2f((m_reg - mn) * C); m_reg = mn; }
    const float mnC = -mn * C;
#pragma unroll
    for (int r = 0; r < 16; ++r) p0[r] = fmaf(p0[r], C, mnC);
#pragma unroll
    for (int r = 0; r < 16; ++r) p1[r] = fmaf(p1[r], C, mnC);
#pragma unroll
    for (int r = 0; r < 16; ++r) p0[r] = __builtin_amdgcn_exp2f(p0[r]);
}
DI void finishSM(f32x16& p0, f32x16& p1, float alpha, float& l_reg, bf16x8& pa0, bf16x8& pa1, bf16x8& pa2, bf16x8& pa3) {
#pragma unroll
    for (int r = 0; r < 16; ++r) p1[r] = __builtin_amdgcn_exp2f(p1[r]);
    float ps = 0;
#pragma unroll
    for (int r = 0; r < 16; ++r) ps += p0[r];
#pragma unroll
    for (int r = 0; r < 16; ++r) ps += p1[r];
    { auto rr = __builtin_amdgcn_permlane32_swap(__float_as_uint(ps), __float_as_uint(ps), false, false);
      ps = __uint_as_float(rr[0]) + __uint_as_float(rr[1]); }
    l_reg = l_reg * alpha + ps;
#define PK4(P, BASE, OUT) do { unsigned a0 = cvtpk(P[BASE + 0], P[BASE + 1]), a1 = cvtpk(P[BASE + 2], P[BASE + 3]);   \
    unsigned b0 = cvtpk(P[BASE + 4], P[BASE + 5]), b1 = cvtpk(P[BASE + 6], P[BASE + 7]);                              \
    auto r0 = __builtin_amdgcn_permlane32_swap(a0, b0, false, false); auto r1 = __builtin_amdgcn_permlane32_swap(a1, b1, false, false); \
    v4u w = {r0[0], r1[0], r0[1], r1[1]}; OUT = *reinterpret_cast<bf16x8*>(&w); } while (0)
    PK4(p0, 0, pa0); PK4(p0, 8, pa1); PK4(p1, 0, pa2); PK4(p1, 8, pa3);
#undef PK4
}
DI void qkt(f32x16& p0, f32x16& p1, const char* Ks, const bf16x8* qr, int r32, int hi) {
    p0 = f32x16{}; p1 = f32x16{};
#pragma unroll
    for (int d0 = 0; d0 < 8; ++d0) { const int cb = (d0 * 16 + hi * 8) * 2;
        const bf16x8 b0 = *reinterpret_cast<const bf16x8*>(Ks + KSWZ(r32, cb));
        const bf16x8 b1 = *reinterpret_cast<const bf16x8*>(Ks + KSWZ(32 + r32, cb));
        p0 = __builtin_amdgcn_mfma_f32_32x32x16_bf16(b0, qr[d0], p0, 0, 0, 0);
        p1 = __builtin_amdgcn_mfma_f32_32x32x16_bf16(b1, qr[d0], p1, 0, 0, 0); }
}
DI int v_st(int k, int c) { const int kk = (k & ~0xC) | ((k & 4) << 1) | ((k & 8) >> 1); return ((kk >> 3) * 4 + (c >> 5)) * 512 + ((kk & 7) * 32 + (c & 31)) * 2; }
DI int v_rd_base(int lane) { return ((lane & 3) << 3) | (((lane >> 2) & 3) << 6) | (((lane >> 4) & 1) << 5) | (((lane >> 5) & 1) << 8); }
constexpr int v_rd_off(int d0, int ks, int half) { return d0 * 512 + ks * 4096 + half * 2048; }
template <int OFF> DI s16x4 tr_read(int vb) { s16x4 r; asm volatile("ds_read_b64_tr_b16 %0, %1 offset:%2" : "=&v"(r) : "v"(vb), "i"(OFF) : "memory"); return r; }
template <int D0> DI void pv_one(f32x16& od, int vb, bf16x8 pa0, bf16x8 pa1, bf16x8 pa2, bf16x8 pa3) {
    const s16x4 l0 = tr_read<v_rd_off(D0, 0, 0)>(vb), h0 = tr_read<v_rd_off(D0, 0, 1)>(vb), l1 = tr_read<v_rd_off(D0, 1, 0)>(vb), h1 = tr_read<v_rd_off(D0, 1, 1)>(vb);
    const s16x4 l2 = tr_read<v_rd_off(D0, 2, 0)>(vb), h2 = tr_read<v_rd_off(D0, 2, 1)>(vb), l3 = tr_read<v_rd_off(D0, 3, 0)>(vb), h3 = tr_read<v_rd_off(D0, 3, 1)>(vb);
    asm volatile("s_waitcnt lgkmcnt(0)" ::: "memory"); SBAR();
#define PKV(L, H) (bf16x8){L[0], L[1], L[2], L[3], H[0], H[1], H[2], H[3]}
    od = __builtin_amdgcn_mfma_f32_32x32x16_bf16(PKV(l0, h0), pa0, od, 0, 0, 0);
    od = __builtin_amdgcn_mfma_f32_32x32x16_bf16(PKV(l1, h1), pa1, od, 0, 0, 0);
    od = __builtin_amdgcn_mfma_f32_32x32x16_bf16(PKV(l2, h2), pa2, od, 0, 0, 0);
    od = __builtin_amdgcn_mfma_f32_32x32x16_bf16(PKV(l3, h3), pa3, od, 0, 0, 0);
#undef PKV
}
DI void pv_d0(f32x16* o, int vb, bf16x8 pa0, bf16x8 pa1, bf16x8 pa2, bf16x8 pa3) {
    pv_one<0>(o[0], vb, pa0, pa1, pa2, pa3); pv_one<1>(o[1], vb, pa0, pa1, pa2, pa3); pv_one<2>(o[2], vb, pa0, pa1, pa2, pa3); pv_one<3>(o[3], vb, pa0, pa1, pa2, pa3);
}
DI void attn_unit(Frame& F, int F_layer, int b, int qb, char* lds) {
    const int wid = F.wave, lane = lane_id(), tid = wid * 64 + lane, r32 = lane & 31, hi = lane >> 5;
    const bf16* QQ = (const bf16*)(wsl(F.ws) + WS_QQ); const bf16* Kh = (const bf16*)(wsl(F.ws) + WS_CKVN) + (size_t)b * SEQ * AD; const unsigned* SELQ = (const unsigned*)(wsl(F.ws) + WS_SELQ);
    bf16* YC = (bf16*)(wsl(F.ws) + WS_YC);
    char* V_lds = lds; char* K_lds = lds + 2 * SHM_V;
    float m_reg = -1e6f, l_reg = 0; f32x16 o[4] = {}; bf16x8 qr[8];
    const int sq = qb * 32 + r32;
    const bf16* Qw = QQ + ((size_t)b * SEQ + sq) * 1280 + wid * AD + hi * 8;
#pragma unroll
    for (int d0 = 0; d0 < 8; ++d0) qr[d0] = *(const GAS bf16x8*)(Qw + d0 * 16);
    int NT = (qb >> 1) + 1; NT += NT & 1;
    int wl = wid + 1; asm volatile("" : "+s"(wl));
    const float na = -exp2f(-(float)wl) / ATT_SCALE, tq = (float)sq;
    const GAS unsigned* selp = (const GAS unsigned*)SELQ + (size_t)b * 32 * 2 * SEQ + sq;
    const int sr = tid >> 4, scc = (tid & 15) * 8, vst0 = v_st(sr, scc), vst1 = v_st(32 + sr, scc);
    const int vb0 = (int)(uintptr_t)V_lds + v_rd_base(lane);
    bf16x8 st0[2], st1[2];
#define SLOAD(i, k0) do { st0[i] = *(const GAS bf16x8*)(Kh + (size_t)((k0) + sr) * AD + scc); st1[i] = *(const GAS bf16x8*)(Kh + (size_t)((k0) + 32 + sr) * AD + scc); } while (0)
#define SWRITE(bb, i) do { *(bf16x8*)(V_lds + (bb) * SHM_V + vst0) = st0[i]; *(bf16x8*)(V_lds + (bb) * SHM_V + vst1) = st1[i]; const int kc = scc * 2; \
    *(bf16x8*)(K_lds + (bb) * SHM_K + KSWZ(sr, kc)) = st0[i]; *(bf16x8*)(K_lds + (bb) * SHM_K + KSWZ(32 + sr, kc)) = st1[i]; } while (0)
#define SWAIT() asm volatile("s_waitcnt vmcnt(2)" ::: "memory")
#define RESC(a) do { if (__any((a) < 1.f)) { _Pragma("unroll") for (int d = 0; d < 4; ++d) _Pragma("unroll") for (int r = 0; r < 16; ++r) o[d][r] *= (a); } } while (0)
#define MASKW(j, wa, wb) do { wa = selp[(size_t)((j) * 2) * SEQ]; wb = selp[(size_t)((j) * 2 + 1) * SEQ]; } while (0)
    f32x16 pA0, pA1, pB0, pB1; float mnA, mnB, alA, alB; bf16x8 pa0, pa1, pa2, pa3; unsigned wA0, wA1, wB0, wB1;
    constexpr int SE = 0, SO = 1;
    MASKW(0, wA0, wA1);
    SLOAD(SE, 0); asm volatile("s_waitcnt vmcnt(0)" ::: "memory"); SWRITE(0, SE); __syncthreads();
    qkt(pA0, pA1, K_lds, qr, r32, hi); partialSM(pA0, pA1, m_reg, mnA, alA, wA0, wA1, tq, na, hi);
    SLOAD(SO, KVBLK); if (2 < NT) SLOAD(SE, 2 * KVBLK);
    asm volatile("s_waitcnt vmcnt(2)" ::: "memory"); SWRITE(1, SO); __syncthreads();
    for (int j = 1; j + 1 < NT; j += 2) {
        MASKW(j, wB0, wB1);
        SBAR(); qkt(pB0, pB1, K_lds + SHM_K, qr, r32, hi);
        finishSM(pA0, pA1, alA, l_reg, pa0, pa1, pa2, pa3); SBAR();
        SLOAD(SO, (j + 2) * KVBLK); SBAR();
        pv_d0(o, vb0, pa0, pa1, pa2, pa3); partialSM(pB0, pB1, m_reg, mnB, alB, wB0, wB1, tq - (float)(64 * j), na, hi);
        __syncthreads(); SWAIT(); SWRITE(0, SE);
        RESC(alB); __syncthreads();
        MASKW(j + 1, wA0, wA1);
        SBAR(); qkt(pA0, pA1, K_lds, qr, r32, hi);
        finishSM(pB0, pB1, alB, l_reg, pa0, pa1, pa2, pa3); SBAR();
        if (j + 3 < NT) SLOAD(SE, (j + 3) * KVBLK); SBAR();
        pv_d0(o, vb0 + (int)SHM_V, pa0, pa1, pa2, pa3); partialSM(pA0, pA1, m_reg, mnA, alA, wA0, wA1, tq - (float)(64 * (j + 1)), na, hi);
        __syncthreads(); if (j + 3 < NT) SWAIT(); else asm volatile("s_waitcnt vmcnt(0)" ::: "memory"); SWRITE(1, SO);
        RESC(alA); __syncthreads();
    }
    MASKW(NT - 1, wB0, wB1);
    SBAR(); qkt(pB0, pB1, K_lds + SHM_K, qr, r32, hi);
    finishSM(pA0, pA1, alA, l_reg, pa0, pa1, pa2, pa3); SBAR();
    pv_d0(o, vb0, pa0, pa1, pa2, pa3); partialSM(pB0, pB1, m_reg, mnB, alB, wB0, wB1, tq - (float)(64 * (NT - 1)), na, hi);
    __syncthreads(); RESC(alB);
    finishSM(pB0, pB1, alB, l_reg, pa0, pa1, pa2, pa3); SBAR();
    pv_d0(o, vb0 + (int)SHM_V, pa0, pa1, pa2, pa3);
    { const float inv = __builtin_amdgcn_rcpf(l_reg) * (MERGE_FP8 ? Y8_SCALE : 1.0f);
      f32x16 y0 = {}, y1 = {};
      const bf16* wf = wslot(F, F_layer, W_UVF) + ((size_t)(wid * 16) * 64 + lane) * 8;
      bf16x8 af[16];
#pragma unroll
      for (int i = 0; i < 16; ++i) af[i] = *(const GAS bf16x8*)(wf + (size_t)(i * 64) * 8);
      asm volatile("" ::: "memory");
#pragma unroll
      for (int d0 = 0; d0 < 4; ++d0)
#pragma unroll
          for (int sx = 0; sx < 2; ++sx) {
              v4u pk; pk.x = cvtpk_c(o[d0][8 * sx + 0] * inv, o[d0][8 * sx + 1] * inv); pk.y = cvtpk_c(o[d0][8 * sx + 2] * inv, o[d0][8 * sx + 3] * inv);
              pk.z = cvtpk_c(o[d0][8 * sx + 4] * inv, o[d0][8 * sx + 5] * inv); pk.w = cvtpk_c(o[d0][8 * sx + 6] * inv, o[d0][8 * sx + 7] * inv);
              const bf16x8 xb = *reinterpret_cast<bf16x8*>(&pk);
              const bf16x8 a0 = af[0 * 8 + d0 * 2 + sx], a1 = af[1 * 8 + d0 * 2 + sx];
              y0 = __builtin_amdgcn_mfma_f32_32x32x16_bf16(a0, xb, y0, 0, 0, 0);
              y1 = __builtin_amdgcn_mfma_f32_32x32x16_bf16(a1, xb, y1, 0, 0, 0); }
      if (MERGE_FP8) { GAS unsigned char* yp8 = (GAS unsigned char*)YC + ((size_t)b * SEQ + sq) * 1024 + wid * 64 + 32 * hi;
          unsigned w[8];
#pragma unroll
          for (int g = 0; g < 4; ++g) { int p0 = __builtin_amdgcn_cvt_pk_fp8_f32(pg8::sat8(y0[4 * g]), pg8::sat8(y0[4 * g + 1]), 0, false); p0 = __builtin_amdgcn_cvt_pk_fp8_f32(pg8::sat8(y0[4 * g + 2]), pg8::sat8(y0[4 * g + 3]), p0, true);
              int p1 = __builtin_amdgcn_cvt_pk_fp8_f32(pg8::sat8(y1[4 * g]), pg8::sat8(y1[4 * g + 1]), 0, false); p1 = __builtin_amdgcn_cvt_pk_fp8_f32(pg8::sat8(y1[4 * g + 2]), pg8::sat8(y1[4 * g + 3]), p1, true);
              const auto rr = __builtin_amdgcn_permlane32_swap((unsigned)p0, (unsigned)p1, false, false); w[2 * g] = rr[0]; w[2 * g + 1] = rr[1]; }
          *(GAS v4u*)(yp8) = (v4u){w[0], w[1], w[2], w[3]}; *(GAS v4u*)(yp8 + 16) = (v4u){w[4], w[5], w[6], w[7]}; }
      else {
      bf16* yp = YC + ((size_t)b * SEQ + sq) * 1024 + wid * 64 + 4 * hi;
#pragma unroll
      for (int g = 0; g < 4; ++g) { u32x2v w0, w1; w0.x = cvtpk_c(y0[4 * g], y0[4 * g + 1]); w0.y = cvtpk_c(y0[4 * g + 2], y0[4 * g + 3]); w1.x = cvtpk_c(y1[4 * g], y1[4 * g + 1]); w1.y = cvtpk_c(y1[4 * g + 2], y1[4 * g + 3]);
          *(GAS u32x2v*)(yp + 8 * g) = w0; *(GAS u32x2v*)(yp + 32 + 8 * g) = w1; } } }
    __syncthreads();
#undef SLOAD
#undef SWRITE
#undef SWAIT
#undef RESC
#undef MASKW
}
DI void attn_phase(Frame& F, int layer) {
#pragma nounroll
    for (int i2 = F.vcu; i2 < 256; i2 += F.G) {
#pragma nounroll
        for (int e = 0; e < 8; ++e) { int b, qb; dsa_unit(i2, e, b, qb); attn_unit(F, layer, b, qb, (char*)(F.lds + RING_OFF)); } }
}

#ifndef REP_GEMM
#define REP_GEMM 1
#endif
#ifndef REP_ATT
#define REP_ATT 1
#endif
#ifndef REP_THIN
#define REP_THIN 1
#endif
#ifndef REP_P0
#define REP_P0 1
#endif
#ifndef REP_NORM
#define REP_NORM 1
#endif
#ifndef REP_IDX
#define REP_IDX 1
#endif
#ifndef REP_EXP
#define REP_EXP 1
#endif
#ifndef REP_N9
#define REP_N9 1
#endif
#ifndef REP_G7
#define REP_G7 1
#endif
#ifndef REP_G9
#define REP_G9 1
#endif
#ifndef REP_BAR
#define REP_BAR 1
#endif
#ifndef REP_G8
#define REP_G8 1
#endif
#ifndef REP_G12
#define REP_G12 1
#endif
#ifndef REP_S5
#define REP_S5 1
#endif
#ifndef STAGGER_US
#define STAGGER_US 0
#endif
#define STAGGER() do { if (STAGGER_US > 0 && (F.vcu & 1)) { _Pragma("nounroll") for (int _i = 0; _i < STAGGER_US / 4; ++_i) __builtin_amdgcn_s_sleep(127); } } while (0)
#define REPEAT(n) _Pragma("nounroll") for (int _r = 0, _n = ({ int _t = (n); asm volatile("" : "+s"(_t)); _t; }); _r < _n; ++_r)
#ifndef PHMASK
#define PHMASK 0xFFFFFFFF
#endif
#define PH(n) (((PHMASK) >> (n)) & 1)
#ifndef FEAT_MIXER
#define FEAT_MIXER 1
#endif
__global__ void __launch_bounds__(NWAVES * 64, 2) fwd_kernel(Args args) {
    extern __shared__ __attribute__((aligned(16))) unsigned char lds[];
    Frame F;
    F.lds = (LAS unsigned char*)lds;
    F.MISC = (volatile LAS unsigned*)(F.lds + MISC_OFF);
    F.wave = __builtin_amdgcn_readfirstlane((int)threadIdx.x >> 6);
    F.G = gridDim.x; { const int bx = blockIdx.x; F.vcu = (F.G % 8 == 0) ? (bx % 8) * (F.G / 8) + bx / 8 : bx; }
    F.ws = args.ws; F.out = args.out;
    F.ctl = (gu32*)(args.ws + WS_CTL);
    for (int u = (int)threadIdx.x; u < (LDS_BYTES - LDSCTL_OFF) / 4; u += NWAVES * 64) ((LAS unsigned*)(F.lds + LDSCTL_OFF))[u] = 0u;
    __syncthreads();
    (void)xcd_barrier_post((unsigned*)(F.ctl + CW_BAR), F.MISC + 8);
#define GRID_BAR() do { XcdBarrier _b; _b.bar = (unsigned*)((gu32*)(wsl(args.ws) + WS_CTL) + CW_BAR); _b.x = xb_xcc_id(); _b.wave = F.wave; _b.st = (volatile LAS unsigned*)(F.lds + MISC_OFF) + 8; REPEAT(REP_BAR) { xcd_barrier(_b); } } while (0)
    using namespace pg8;
    unsigned char* ws = args.ws;
    const int bx = (int)blockIdx.x;
#define LBX() ({ int _b = bx; asm volatile("" : "+s"(_b)); _b; })

    REPEAT(REP_P0) { if (PH(0)) p0_prologue(F, args); }
    GRID_BAR();
    REPEAT(REP_P0) { if (PH(1)) p1_kt(F, args); }
    REPEAT(REP_NORM)
    { const float* mod0 = (const float*)(wsl(ws) + WS_MOD);
      if (PH(9)) { _Pragma("nounroll") for (int pm = F.vcu; pm < MTOK / 256; pm += F.G) norm_panel(F, pm, args.in[I_X], nullptr, nullptr, nullptr, nullptr, args.in[I_MIXPRE], mod0 + 1 * DM, mod0 + 0 * DM, (bf16*)(wsl(ws) + WS_H), false, 0); } }
    GRID_BAR();

    for (int l = 0; l < DEPTH; ++l) {
        const float* mod = (const float*)(wsl(ws) + WS_MOD) + (size_t)l * BATCH * NMOD;
        const float* xin = (l == 0) ? args.in[I_X] : F.out;
#if FEAT_MIXER
        REPEAT(REP_EXP) { if (PH(2)) s5_expand(F, args, l); }
REPEAT(REP_GEMM) {
        STAGGER();
#if IN_FP8
        { constexpr int NG = SMALL_FP8 ? 3584 : 3072;
          Gemm g{(const bf16_t*)(wsl(ws) + WS_H8), (const bf16_t*)wslot(F, l, W_IN), MTOK, NG, DM / 2, DM / 2, DM / 2}; StaticOrder S; S.init(MTOK, NG, F.G, LBX());
#if PAIR_GATES
          EpiGates E{(bf16_t*)(wsl(ws) + WS_ZG), (size_t)MTOK * 1024, 1.0f / W8_SCALE};
          if (PH(10)) gemm_phase<EpiGates, StaticOrder, true, true, true>(F.lds + RING_OFF, g, S, E, F.wave); }
#else
          EpiBf16<2> E{(bf16_t*)(wsl(ws) + WS_ZG), 1024, nullptr, 1024, (size_t)MTOK * 1024, 1.f, 1.0f / W8_SCALE, 3, 512};
          if (PH(10)) gemm_phase<EpiBf16<2>, StaticOrder, true, true, true>(F.lds + RING_OFF, g, S, E, F.wave); }
#endif
        { constexpr int NS = SMALL_FP8 ? 512 : 1024;
          Gemm g{(const bf16_t*)(wsl(ws) + WS_H), (const bf16_t*)wslot(F, l, W_IN) + (size_t)3072 * DM, MTOK, NS, DM, DM, DM}; StaticOrder S; S.init(MTOK, NS, F.G, LBX());
          EpiBf16<0> E{(bf16_t*)(wsl(ws) + WS_ZS), 1024, nullptr, 0, 0, 1.f};
          if (PH(10)) gemm_phase<EpiBf16<0>, StaticOrder, true, true>(F.lds + RING_OFF, g, S, E, F.wave); }
#else
        { Gemm g{(const bf16_t*)(wsl(ws) + WS_H), (const bf16_t*)wslot(F, l, W_IN), MTOK, 4096, DM, DM, DM}; StaticOrder S; S.init(MTOK, 4096, F.G, LBX());
          EpiBf16<0> E{(bf16_t*)(wsl(ws) + WS_ZG), 1024, nullptr, 1024, (size_t)MTOK * 1024, 1.f};
          if (PH(10)) gemm_phase<EpiBf16<0>, StaticOrder, true, true>(F.lds + RING_OFF, g, S, E, F.wave); }
#endif
        }
        GRID_BAR();
REPEAT(REP_THIN) {
        if (PH(3)) small_ops(F, args, l);
        }
        GRID_BAR();
REPEAT(REP_S5) {
        { Gemm g{(const bf16_t*)(wsl(ws) + WS_AS5), (const bf16_t*)(wsl(ws) + WS_WE), 16384, 4096, 1024, AS5_LD, 1024}; GroupOrder<1> S{F.G, LBX()};
          EpiE E{(float*)(wsl(ws) + WS_E)};
          if (PH(11)) gemm_phase<EpiE, GroupOrder<1>, false, true>(F.lds + RING_OFF, g, S, E, F.wave); }
        { Gemm g{(const bf16_t*)(wsl(ws) + WS_POOLED), (const bf16_t*)wslot(F, l, W_POOL), MTOK, 256, 256, 256, 256}; StaticOrder S; S.init(MTOK, 256, F.G, LBX());
#if MERGE_FP8
          EpiF8 E{(unsigned char*)(wsl(ws) + WS_YC) + 768, 1024, Y8_SCALE};
          if (PH(12)) gemm_phase<EpiF8, StaticOrder, true, true>(F.lds + RING_OFF, g, S, E, F.wave); }
#else
          EpiBf16<0> E{(bf16_t*)(wsl(ws) + WS_YC) + 768, 1024, nullptr, 0, 0, 1.f};
          if (PH(12)) gemm_phase<EpiBf16<0>, StaticOrder, true, true>(F.lds + RING_OFF, g, S, E, F.wave); }
#endif
        { Gemm g{(const bf16_t*)(wsl(ws) + WS_CQN), (const bf16_t*)wslot(F, l, W_Q), MTOK, 1280, 256, 256, 256}; QQOrder S{F.G, LBX()};
          EpiBf16<0> E{(bf16_t*)(wsl(ws) + WS_QQ), 1280, nullptr, 0, 0, 1.f};
          if (PH(13)) gemm_phase<EpiBf16<0>, QQOrder, true, true>(F.lds + RING_OFF, g, S, E, F.wave); }
        }
        GRID_BAR();
REPEAT(REP_S5) {
        if (PH(4)) s5_scan(F, l);
        }
REPEAT(REP_IDX) {
        if (PH(5)) indexer_phase(F);
        }
        GRID_BAR();
REPEAT(REP_S5) {
        { Gemm g{(const bf16_t*)(wsl(ws) + WS_AS5), (const bf16_t*)(wsl(ws) + WS_WY), 16384, 16384, AS5_LD, AS5_LD, AS5_LD}; GroupOrder<4> S{F.G, LBX()};
          EpiS5Y E{(bf16_t*)(wsl(ws) + WS_ZSS)};
          if (PH(14)) gemm_phase<EpiS5Y, GroupOrder<4>, false, true>(F.lds + RING_OFF, g, S, E, F.wave); }
        }
REPEAT(REP_ATT) {
        if (PH(6)) attn_phase(F, l);
        }
        GRID_BAR();
#pragma nounroll
        for (int pm = F.vcu; pm < MTOK / 256; pm += F.G) {
            { Gemm g{(const bf16_t*)(wsl(ws) + WS_ZSS), (const bf16_t*)wslot(F, l, W_GLU), MTOK, 256, 256, 256, 256}; PanelOrder S{pm, 1};
              EpiGlu E{(const bf16_t*)(wsl(ws) + WS_ZSS), MERGE_FP8 ? (bf16_t*)((unsigned char*)(wsl(ws) + WS_YC) + 512) : (bf16_t*)(wsl(ws) + WS_YC) + 512, args.in[I_BGLU] + l * 256, 1024};
              REPEAT(REP_G7) { if (PH(15)) gemm_phase<EpiGlu, PanelOrder, true, true>(F.lds + RING_OFF, g, S, E, F.wave); } }
            panel_sync();
            { constexpr int KM = MERGE_FP8 ? DM / 2 : DM;
              Gemm g{(const bf16_t*)(wsl(ws) + WS_YC), (const bf16_t*)wslot(F, l, W_M), MTOK, DM, KM, KM, KM}; PanelOrder S{pm, 4};
              EpiMerge E{(const bf16_t*)(wsl(ws) + WS_ZG), (bf16_t*)(wsl(ws) + WS_MG), (size_t)MTOK * 1024, MERGE_FP8 ? 1.0f / (W8_SCALE * Y8_SCALE) : 1.f, (const bf16_t*)(wsl(ws) + WS_CTL + 65536)};
              REPEAT(REP_G8) { if (PH(16)) gemm_phase<EpiMerge, PanelOrder, true, true, MERGE_FP8 != 0>(F.lds + RING_OFF, g, S, E, F.wave); } }
            panel_sync();
            { constexpr int KO = OUT_FP8 ? DM / 2 : DM;
              Gemm g{(const bf16_t*)(wsl(ws) + WS_MG), (const bf16_t*)wslot(F, l, W_OUT), MTOK, DM, KO, KO, KO}; PanelOrder S{pm, 4};
              EpiBf16<0> E{(bf16_t*)(wsl(ws) + WS_Y), DM, nullptr, 0, 0, 1.f, OUT_FP8 ? 1.0f / W8_SCALE : 1.f};
              REPEAT(REP_G9) { if (PH(19)) gemm_phase<EpiBf16<0>, PanelOrder, true, true, OUT_FP8 != 0>(F.lds + RING_OFF, g, S, E, F.wave); } }
            panel_sync();
            REPEAT(l == 0 ? REP_N9 : 1) if (PH(9)) norm_panel(F, pm, xin, (const bf16*)(wsl(ws) + WS_Y), mod + 2 * DM, args.in[I_MIXPOST] + l * DM, F.out, args.in[I_FFNPRE] + l * DM, mod + 4 * DM, mod + 3 * DM, (bf16*)(wsl(ws) + WS_H), true, (l == 0 ? 0 : 1) | 2);
        }
        GRID_BAR();
#else
        { const int gw = F.vcu * NWAVES + F.wave, NGW = F.G * NWAVES;
          if (l == 0) for (int m = gw; m < MTOK; m += NGW) { const GAS f32x4* xr = (const GAS f32x4*)(xin + (size_t)m * DM) + lane_id(); GAS f32x4* xo = (GAS f32x4*)(F.out + (size_t)m * DM) + lane_id();
#pragma unroll
              for (int j = 0; j < 4; ++j) xo[64 * j] = xr[64 * j]; } }
        if (PH(9)) norm_rows(F, xin, nullptr, nullptr, nullptr, nullptr, args.in[I_FFNPRE] + l * DM, mod + 4 * DM, mod + 3 * DM, (bf16*)(wsl(ws) + WS_H));
        GRID_BAR();
#endif
REPEAT(REP_GEMM) {
        STAGGER();
        { constexpr int KU = UP_FP8 ? DM / 2 : DM;
          Gemm g{(const bf16_t*)(wsl(ws) + WS_H), (const bf16_t*)wslot(F, l, W_UP), MTOK, 4096, KU, KU, KU}; StaticOrder S; S.init(MTOK, 4096, F.G, LBX());
          EpiConv E{args.in[I_CONVW] + (size_t)l * 3 * 4096, args.in[I_CONVB] + (size_t)l * 4096, (bf16_t*)(wsl(ws) + WS_A2), (float*)(wsl(ws) + WS_HALO), UP_FP8 ? 1.0f / W8_SCALE : 1.f};
          if (PH(20)) gemm_phase<EpiConv, StaticOrder, true, true, UP_FP8 != 0>(F.lds + RING_OFF, g, S, E, F.wave); }
        }
        GRID_BAR();
#pragma nounroll
        for (int pm = F.vcu; pm < MTOK / 256; pm += F.G) {
            REPEAT(REP_G12) { if (PH(7)) conv_fixup(F, args, l, pm); }
            panel_sync();
            { constexpr int KV = DOWN_FP8 ? DFF / 2 : DFF;
              Gemm g{(const bf16_t*)(wsl(ws) + WS_A2), (const bf16_t*)wslot(F, l, W_DOWN), MTOK, DM, KV, KV, KV}; PanelOrder S{pm, 4};
              EpiBf16<0> E{(bf16_t*)(wsl(ws) + WS_Y2), DM, nullptr, 0, 0, 1.f, DOWN_FP8 ? 1.0f / W8_SCALE : 1.f};
              REPEAT(REP_G12) { if (PH(21)) gemm_phase<EpiBf16<0>, PanelOrder, true, true, DOWN_FP8 != 0>(F.lds + RING_OFF, g, S, E, F.wave); } }
            panel_sync();
            if (l + 1 < DEPTH) { const float* modn = mod + (size_t)BATCH * NMOD;
                norm_panel(F, pm, F.out, (const bf16*)(wsl(ws) + WS_Y2), mod + 5 * DM, args.in[I_FFNPOST] + l * DM, F.out, args.in[I_MIXPRE] + (l + 1) * DM, modn + 1 * DM, modn + 0 * DM, (bf16*)(wsl(ws) + WS_H), false, 3); }
            else norm_panel(F, pm, F.out, (const bf16*)(wsl(ws) + WS_Y2), mod + 5 * DM, args.in[I_FFNPOST] + l * DM, F.out, nullptr, nullptr, nullptr, nullptr, false, 1);
        }
        if (l + 1 < DEPTH) GRID_BAR();
    }
}

extern "C" void kernel_launch(void* const* d_in, const int* in_sizes, int n_in, void* d_out, int out_size, void* d_ws, size_t ws_size, hipStream_t stream) {
    static int grid = 0;
    if (grid == 0) {
        if (n_in != N_INPUTS || out_size != MTOK * DM || ws_size < WS_END) { fprintf(stderr, "kernel_launch: unexpected shapes: n_in %d out %d ws %zu (need %zu)\n", n_in, out_size, ws_size, (size_t)WS_END); grid = -1; return; }
        int dev = 0, cus = 0;
        if (hipGetDevice(&dev) != hipSuccess || hipDeviceGetAttribute(&cus, hipDeviceAttributeMultiprocessorCount, dev) != hipSuccess) { grid = -1; return; }
        if (hipFuncSetAttribute((const void*)fwd_kernel, hipFuncAttributeMaxDynamicSharedMemorySize, LDS_BYTES) != hipSuccess) { fprintf(stderr, "kernel_launch: hipFuncSetAttribute failed\n"); grid = -1; return; }
        int per_cu = 0;
        if (hipOccupancyMaxActiveBlocksPerMultiprocessor(&per_cu, (const void*)fwd_kernel, NWAVES * 64, LDS_BYTES) != hipSuccess || per_cu < 1) { fprintf(stderr, "kernel_launch: occupancy query says %d\n", per_cu); }
        (void)hipGetLastError();
        grid = cus;
    }
    if (grid < 0) return;
    (void)hipMemsetAsync((char*)d_ws + WS_CTL, 0, CTL_ZERO_BYTES, stream);
    Args a{};
    for (int i = 0; i < N_INPUTS; ++i) a.in[i] = (const float*)d_in[i];
    a.out = (float*)d_out; a.ws = (unsigned char*)d_ws; a.ph_lo = 0; a.ph_hi = 0; a.li = 0; a.pad = 0;
    hipLaunchKernelGGL(fwd_kernel, dim3(grid), dim3(NWAVES * 64), LDS_BYTES, stream, a);
}
```
